# Optimizing an MI355X kernel written in HIP

```python
import math
import jax, jax.numpy as jnp
from jax import lax
import numpy as np

D_MODEL = 1024
BATCH = 4
SEQ = 8192
DEPTH = 2

D_MIX = D_MODEL
D_FF = 2816
NORM_EPS = 1e-6

POOL_WINDOWS = (2, 4, 8, 16)
POOL_GROUPS = len(POOL_WINDOWS)
POOL_GROUP_DIM = 64
POOL_WIDTH = POOL_GROUPS * POOL_GROUP_DIM

ATTN_HEADS = 8
HEAD_DIM = 64
ATTN_WIDTH = ATTN_HEADS * HEAD_DIM
Q_BLOCK = 128

CONV_WIDTH_CH = D_MIX - POOL_WIDTH - ATTN_WIDTH
CONV_KERNEL = 31

IN_COLS = POOL_WIDTH + 3 * ATTN_WIDTH + ATTN_HEADS + 2 * CONV_WIDTH_CH

kernel_name = "hymba_style_pool_fox_conformer_macaron"


def rms_norm(x, g):
    x32 = x.astype(jnp.float32)
    y = x32 * lax.rsqrt(jnp.mean(x32 * x32, axis=-1, keepdims=True) + NORM_EPS)
    return (y * g.astype(jnp.float32)).astype(x.dtype)


def layer_norm(x, g, b):
    x32 = x.astype(jnp.float32)
    mu = jnp.mean(x32, axis=-1, keepdims=True)
    xc = x32 - mu
    var = jnp.mean(xc * xc, axis=-1, keepdims=True)
    y = xc * lax.rsqrt(var + NORM_EPS)
    return (y * g.astype(jnp.float32) + b.astype(jnp.float32)).astype(x.dtype)


def swiglu(h, w_gate, w_up, w_down):
    return (jax.nn.silu(h @ w_gate) * (h @ w_up)) @ w_down


def causal_window_mean(u, w):
    S = u.shape[1]
    u32 = u.astype(jnp.float32)
    cs = jnp.cumsum(u32, axis=1)
    lagged = jnp.pad(cs, ((0, 0), (w, 0), (0, 0)))[:, :S]
    count = jnp.minimum(jnp.arange(S) + 1, w).astype(jnp.float32)
    return ((cs - lagged) / count[None, :, None]).astype(u.dtype)


def pool_mixer(u, pool_w, pool_scale):
    B, S, _ = u.shape
    ug = u.reshape(B, S, POOL_GROUPS, POOL_GROUP_DIM)
    pooled = jnp.stack(
        [causal_window_mean(ug[:, :, g], w) - ug[:, :, g] for g, w in enumerate(POOL_WINDOWS)],
        axis=2)
    mixed = jnp.einsum('bsgc,gcd->bsgd', pooled, pool_w)
    return mixed.reshape(B, S, POOL_WIDTH) * pool_scale


def forgetting_attention(q, k, v, z_f, forget_bias):
    B, S, H, Dh = q.shape
    n_blk = S // Q_BLOCK
    scale = 1.0 / math.sqrt(Dh)
    log_f = jax.nn.log_sigmoid(z_f.astype(jnp.float32) + forget_bias.astype(jnp.float32))
    F = jnp.cumsum(log_f, axis=1).transpose(0, 2, 1)
    qh = q.transpose(0, 2, 1, 3)
    kh = k.transpose(0, 2, 1, 3)
    vh = v.transpose(0, 2, 1, 3)
    q_blocks = qh.reshape(B, H, n_blk, Q_BLOCK, Dh).transpose(2, 0, 1, 3, 4)
    F_blocks = F.reshape(B, H, n_blk, Q_BLOCK).transpose(2, 0, 1, 3)
    k_pos = jnp.arange(S)

    def one_block(args):
        q_i, F_i, i = args
        s = jnp.einsum('bhqd,bhkd->bhqk', q_i, kh).astype(jnp.float32) * scale
        s = s + F_i[..., None] - F[:, :, None, :]
        q_pos = i * Q_BLOCK + jnp.arange(Q_BLOCK)
        mask = k_pos[None, :] <= q_pos[:, None]
        s = jnp.where(mask[None, None], s, -jnp.inf)
        p = jax.nn.softmax(s, axis=-1)
        return jnp.einsum('bhqk,bhkd->bhqd', p.astype(vh.dtype), vh)

    out = lax.map(one_block, (q_blocks, F_blocks, jnp.arange(n_blk)))
    return out.transpose(1, 0, 3, 2, 4).reshape(B, S, H * Dh)


def conformer_conv(h_glu, conv_w, conv_b, ln_g, ln_b):
    a, g = jnp.split(h_glu, 2, axis=-1)
    u = a * jax.nn.sigmoid(g)
    y = lax.conv_general_dilated(
        u, conv_w[:, None, :].astype(u.dtype), window_strides=(1,),
        padding=[(CONV_KERNEL - 1, 0)], dimension_numbers=('NWC', 'WIO', 'NWC'),
        feature_group_count=CONV_WIDTH_CH) + conv_b
    return jax.nn.silu(layer_norm(y, ln_g, ln_b))


def token_mixer(h, w_in, pool_w, pool_scale, forget_bias, conv_w, conv_b, conv_ln_g, conv_ln_b, w_out):
    B, S, _ = h.shape
    p = h @ w_in
    o = 0
    u_pool = p[..., o:o + POOL_WIDTH]; o += POOL_WIDTH
    q = p[..., o:o + ATTN_WIDTH]; o += ATTN_WIDTH
    k = p[..., o:o + ATTN_WIDTH]; o += ATTN_WIDTH
    v = p[..., o:o + ATTN_WIDTH]; o += ATTN_WIDTH
    z_f = p[..., o:o + ATTN_HEADS]; o += ATTN_HEADS
    h_glu = p[..., o:o + 2 * CONV_WIDTH_CH]
    shp = (B, S, ATTN_HEADS, HEAD_DIM)
    y_a = pool_mixer(u_pool, pool_w, pool_scale)
    y_b = forgetting_attention(q.reshape(shp), k.reshape(shp), v.reshape(shp), z_f, forget_bias)
    y_c = conformer_conv(h_glu, conv_w, conv_b, conv_ln_g, conv_ln_b)
    return jnp.concatenate([y_a, y_b, y_c], axis=-1) @ w_out


def setup_inputs(seed: int = 0) -> dict:
    key = jax.random.key(seed)
    ks = jax.random.split(key, 24)

    def nrm(k, shape, scale):
        return jax.random.normal(k, shape, jnp.float32) * scale

    def gain(k, shape):
        return 1.0 + 0.02 * jax.random.normal(k, shape, jnp.float32)

    L = DEPTH
    return {
        "x": nrm(ks[0], (BATCH, SEQ, D_MODEL), 1.0),
        "ffn1_norm": gain(ks[1], (L, D_MODEL)),
        "ffn1_w_gate": nrm(ks[2], (L, D_MODEL, D_FF), D_MODEL ** -0.5),
        "ffn1_w_up": nrm(ks[3], (L, D_MODEL, D_FF), D_MODEL ** -0.5),
        "ffn1_w_down": nrm(ks[4], (L, D_FF, D_MODEL), D_FF ** -0.5),
        "mix_norm": gain(ks[5], (L, D_MODEL)),
        "w_in": nrm(ks[6], (L, D_MODEL, IN_COLS), D_MODEL ** -0.5),
        "pool_w": nrm(ks[7], (L, POOL_GROUPS, POOL_GROUP_DIM, POOL_GROUP_DIM), POOL_GROUP_DIM ** -0.5),
        "pool_scale": gain(ks[8], (L, POOL_WIDTH)),
        "forget_bias": 2.0 + 0.1 * jax.random.normal(ks[9], (L, ATTN_HEADS), jnp.float32),
        "conv_w": nrm(ks[10], (L, CONV_KERNEL, CONV_WIDTH_CH), CONV_KERNEL ** -0.5),
        "conv_b": nrm(ks[11], (L, CONV_WIDTH_CH), 0.02),
        "conv_ln_g": gain(ks[12], (L, CONV_WIDTH_CH)),
        "conv_ln_b": nrm(ks[13], (L, CONV_WIDTH_CH), 0.02),
        "w_out": nrm(ks[14], (L, D_MIX, D_MODEL), D_MIX ** -0.5),
        "ffn2_norm": gain(ks[15], (L, D_MODEL)),
        "ffn2_w_gate": nrm(ks[16], (L, D_MODEL, D_FF), D_MODEL ** -0.5),
        "ffn2_w_up": nrm(ks[17], (L, D_MODEL, D_FF), D_MODEL ** -0.5),
        "ffn2_w_down": nrm(ks[18], (L, D_FF, D_MODEL), D_FF ** -0.5),
        "final_norm": gain(ks[19], (D_MODEL,)),
    }


def reference(x, ffn1_norm, ffn1_w_gate, ffn1_w_up, ffn1_w_down, mix_norm, w_in, pool_w, pool_scale,
              forget_bias, conv_w, conv_b, conv_ln_g, conv_ln_b, w_out, ffn2_norm, ffn2_w_gate,
              ffn2_w_up, ffn2_w_down, final_norm):
    for l in range(DEPTH):
        x = x + 0.5 * swiglu(rms_norm(x, ffn1_norm[l]), ffn1_w_gate[l], ffn1_w_up[l], ffn1_w_down[l])
        x = x + token_mixer(rms_norm(x, mix_norm[l]), w_in[l], pool_w[l], pool_scale[l], forget_bias[l],
                            conv_w[l], conv_b[l], conv_ln_g[l], conv_ln_b[l], w_out[l])
        x = x + 0.5 * swiglu(rms_norm(x, ffn2_norm[l]), ffn2_w_gate[l], ffn2_w_up[l], ffn2_w_down[l])
    return rms_norm(x, final_norm)
```

```cpp
#include <hip/hip_runtime.h>
#include <hip/hip_cooperative_groups.h>
#include <hip/hip_bf16.h>
#include <cstdio>
#include <cstdint>
#include <cmath>
namespace cg = cooperative_groups;
namespace pg8 {
#define PG8_LAS __attribute__((address_space(3)))
typedef unsigned short bf16_t;
typedef short bf16x8 __attribute__((ext_vector_type(8)));
typedef float f32x4 __attribute__((ext_vector_type(4)));
typedef unsigned u32x4 __attribute__((ext_vector_type(4)));
constexpr int BM = 256, BK = 64, HALF = 128, HTB = HALF * BK * 2  , STAGE_BYTES = 8 * HTB, NXCD = 8, WGM = 8;

__host__ __device__ __forceinline__ int lds_byte(int r, int c) { const int st = (r >> 4) * 2 + (c >> 5), rr = r & 15, cc = c & 31, ob = rr * 64 + cc * 2; return st * 1024 + (ob ^ (((ob >> 9) & 1) << 5)); }
__host__ __device__ __forceinline__ void stage_rc(int b, int& R, int& C) { const int st = b / 1024, sb = b % 1024, swz = sb ^ (((sb >> 9) & 1) << 5); R = (st >> 1) * 16 + swz / 64; C = (st & 1) * 32 + (swz % 64) / 2; }
__host__ __device__ __forceinline__ int perm32(int rho) { const int n = rho >> 4, i = rho & 15; return 8 * (i >> 2) + 4 * n + (i & 3); }

struct Unit { int pm, pn; };
struct Gemm { const bf16_t* A; const bf16_t* Bt; int M, N, K; };

struct StaticOrder {
    int nM, nN, nwg, G, c;
    __host__ __device__ void init(int M, int N, int G_, int c_) { nM = M / BM; nN = N / BM; nwg = nM * nN; G = G_; c = c_; }
    __host__ __device__ bool next(int i, Unit& u) const {
        const long L = (long)i * G + c; if (L >= nwg) return false;
        int wgid = (int)L; { const int q = nwg / NXCD, r = nwg % NXCD, xcd = wgid % NXCD, off = wgid / NXCD; wgid = (xcd < r ? xcd * (q + 1) : r * (q + 1) + (xcd - r) * q) + off; }
        const int nig = WGM * nN, gid = wgid / nig, fm = gid * WGM, gsz = (nM - fm) < WGM ? (nM - fm) : WGM;
        u.pm = fm + ((wgid % nig) % gsz); u.pn = (wgid % nig) / gsz; return true;
    }
    __device__ __forceinline__ void a_ready(const Unit&) const {}
    __device__ __forceinline__ void done(const Unit&) const {}
};

typedef float f32x2cv __attribute__((ext_vector_type(2))); typedef __bf16 bf16x2cv __attribute__((ext_vector_type(2)));
__device__ __forceinline__ unsigned cvt_pk_bf16(float lo, float hi) { const f32x2cv v = {lo, hi}; return __builtin_bit_cast(unsigned, __builtin_convertvector(v, bf16x2cv)); }
typedef float f32x2 __attribute__((ext_vector_type(2)));
__device__ __forceinline__ float sigm(float x) { return __builtin_amdgcn_rcpf(1.0f + __builtin_amdgcn_exp2f(-1.4426950408889634f * x)); }
__device__ __forceinline__ float row_rinv(const float* SS, int row) {
    const f32x4* p = (const f32x4*)(SS + (size_t)row * 16);
    const f32x4 a = p[0], b = p[1], c = p[2], d = p[3];
    const float s = (((a[0] + a[1]) + (a[2] + a[3])) + ((b[0] + b[1]) + (b[2] + b[3]))) + (((c[0] + c[1]) + (c[2] + c[3])) + ((d[0] + d[1]) + (d[2] + d[3])));
    return 1.0f / sqrtf(s * (1.0f / 1024.0f) + 1e-6f);
}
__device__ __forceinline__ float rinv_of(const PG8_LAS float* rt, const float* SS, int pm, int row) { return rt ? rt[((pm >> 3) & 3) * 256 + (row & 255)] : row_rinv(SS, row); }
struct EpiGLU {
    static constexpr bool PERM = true, AFTER_DRAIN = false;
    bf16_t* H; int ldh; const float* SS; const PG8_LAS float* rt;
    __device__ __forceinline__ void operator()(const f32x4 (&acc)[2][2][4][2], const Unit& u, int wr, int wc, int fr, int fq) const {
        const int row0 = u.pm * BM + wr * 64 + fr, col0 = u.pn * HALF + wc * 32 + 8 * fq;
#pragma unroll
        for (int ai = 0; ai < 2; ++ai)
#pragma unroll
            for (int m = 0; m < 4; ++m) { const int row = row0 + ai * HALF + m * 16; const float ri = rinv_of(rt, SS, u.pm, row);
                u32x4 w; unsigned ww[4];
#pragma unroll
                for (int n = 0; n < 2; ++n) { const f32x4 g = acc[ai][0][m][n] * ri, up = acc[ai][1][m][n] * ri; const f32x4 t = g * (-1.4426950408889634f); f32x4 e, r;
#pragma unroll
                    for (int i = 0; i < 4; ++i) e[i] = __builtin_amdgcn_exp2f(t[i]);
                    e = e + 1.0f;
#pragma unroll
                    for (int i = 0; i < 4; ++i) r[i] = __builtin_amdgcn_rcpf(e[i]);
                    const f32x4 hv = (g * up) * r;
                    ww[2 * n] = cvt_pk_bf16(hv[0], hv[1]); ww[2 * n + 1] = cvt_pk_bf16(hv[2], hv[3]); }
                w.x = ww[0]; w.y = ww[1]; w.z = ww[2]; w.w = ww[3];
                *(u32x4*)(H + (size_t)row * ldh + col0) = w;
                if (m & 1) asm volatile("" ::: "memory"); }
    }
};
template <bool BASE_F32, bool OUT_F32> struct EpiRes {
    static_assert(!BASE_F32 && !OUT_F32, "bf16 residual stream only");
    static constexpr bool PERM = true, AFTER_DRAIN = false;
    const float* basef; float* outf; bf16_t* xb; float* SS; float scale;
    __device__ __forceinline__ void operator()(const f32x4 (&acc)[2][2][4][2], const Unit& u, int wr, int wc, int fr, int fq) const {
        const int col0 = u.pn * BM + wc * 32 + 8 * fq;
#pragma unroll
        for (int ai = 0; ai < 2; ++ai)
#pragma unroll
            for (int m = 0; m < 4; ++m) { const int row = u.pm * BM + ai * HALF + wr * 64 + m * 16 + fr; bf16_t* rowp = xb + (size_t)row * 1024 + col0; float s = 0.f;
#pragma unroll
                for (int bj = 0; bj < 2; ++bj) { const u32x4 bw = *(const u32x4*)(rowp + bj * HALF);
                    const f32x4 b0 = {__builtin_bit_cast(float, bw.x << 16), __builtin_bit_cast(float, bw.x & 0xffff0000u), __builtin_bit_cast(float, bw.y << 16), __builtin_bit_cast(float, bw.y & 0xffff0000u)};
                    const f32x4 b1 = {__builtin_bit_cast(float, bw.z << 16), __builtin_bit_cast(float, bw.z & 0xffff0000u), __builtin_bit_cast(float, bw.w << 16), __builtin_bit_cast(float, bw.w & 0xffff0000u)};
                    const f32x4 o0 = b0 + acc[ai][bj][m][0] * scale, o1 = b1 + acc[ai][bj][m][1] * scale;
                    u32x4 w; w.x = cvt_pk_bf16(o0[0], o0[1]); w.y = cvt_pk_bf16(o0[2], o0[3]); w.z = cvt_pk_bf16(o1[0], o1[1]); w.w = cvt_pk_bf16(o1[2], o1[3]);
                    *(u32x4*)(rowp + bj * HALF) = w;
                    const f32x4 r0 = {__builtin_bit_cast(float, w.x << 16), __builtin_bit_cast(float, w.x & 0xffff0000u), __builtin_bit_cast(float, w.y << 16), __builtin_bit_cast(float, w.y & 0xffff0000u)};
                    const f32x4 r1 = {__builtin_bit_cast(float, w.z << 16), __builtin_bit_cast(float, w.z & 0xffff0000u), __builtin_bit_cast(float, w.w << 16), __builtin_bit_cast(float, w.w & 0xffff0000u)};
                    s += ((r0[0] * r0[0] + r0[1] * r0[1]) + (r0[2] * r0[2] + r0[3] * r0[3])) + ((r1[0] * r1[0] + r1[1] * r1[1]) + (r1[2] * r1[2] + r1[3] * r1[3])); }
                s += __shfl_xor(s, 16); s += __shfl_xor(s, 32);
                if (fq == 0) SS[(size_t)row * 16 + 4 * u.pn + wc] = s;
                if (m & 1) asm volatile("" ::: "memory"); }
    }
};
struct EpiWin {
    static constexpr bool PERM = true, AFTER_DRAIN = false;
    bf16_t *UP, *Q, *K, *V, *CU; float* LF2; const float* SS; const float* fb; float qscale; int seq; unsigned* kmax; const PG8_LAS float* rt;
    __device__ __forceinline__ void operator()(const f32x4 (&acc)[2][2][4][2], const Unit& u, int wr, int wc, int fr, int fq) const {
        const int pn = u.pn; const int row0 = u.pm * BM + wr * 64 + fr;
        if (pn <= 6) {
            bf16_t* dst; int ld, colt; float sc = 1.f;
            if (pn == 0) { dst = UP; ld = 256; colt = 0; } else if (pn <= 2) { dst = Q; ld = 512; colt = (pn - 1) * 256; sc = qscale; } else if (pn <= 4) { dst = K; ld = 512; colt = (pn - 3) * 256; } else { dst = V; ld = 512; colt = (pn - 5) * 256; }
            const int col0 = colt + wc * 32 + 8 * fq; const bool isk = (pn == 3 || pn == 4); float hm[2] = {0.f, 0.f};
#pragma unroll
            for (int ai = 0; ai < 2; ++ai)
#pragma unroll
                for (int m = 0; m < 4; ++m) { const int row = row0 + ai * HALF + m * 16; const float ri = rinv_of(rt, SS, u.pm, row) * sc; bf16_t* rowp = dst + (size_t)row * ld + col0;
#pragma unroll
                    for (int bj = 0; bj < 2; ++bj) { const f32x4 v0 = acc[ai][bj][m][0] * ri, v1 = acc[ai][bj][m][1] * ri; u32x4 w;
                        w.x = cvt_pk_bf16(v0[0], v0[1]); w.y = cvt_pk_bf16(v0[2], v0[3]); w.z = cvt_pk_bf16(v1[0], v1[1]); w.w = cvt_pk_bf16(v1[2], v1[3]); *(u32x4*)(rowp + bj * HALF) = w;
                        if (isk) { float q = ((v0[0] * v0[0] + v0[1] * v0[1]) + (v0[2] * v0[2] + v0[3] * v0[3])) + ((v1[0] * v1[0] + v1[1] * v1[1]) + (v1[2] * v1[2] + v1[3] * v1[3]));
                            q += __shfl_xor(q, 16); q += __shfl_xor(q, 32); hm[bj] = __builtin_fmaxf(hm[bj], q); } }
                    if (m & 1) asm volatile("" ::: "memory"); }
            if (isk) {
#pragma unroll
                for (int bj = 0; bj < 2; ++bj) { float q = hm[bj];
#pragma unroll
                    for (int o = 1; o < 16; o <<= 1) q = __builtin_fmaxf(q, __shfl_xor(q, o));
                    if (fr == 0 && fq == 0) __hip_atomic_fetch_max(kmax + ((u.pm * BM) / seq) * 8 + (pn - 3) * 4 + 2 * bj + (wc >> 1), __float_as_uint(q), __ATOMIC_RELAXED, __HIP_MEMORY_SCOPE_AGENT); } }
        } else if (pn <= 8) {
            const int col0 = (pn - 7) * HALF + wc * 32 + 8 * fq;
#pragma unroll
            for (int ai = 0; ai < 2; ++ai)
#pragma unroll
                for (int m = 0; m < 4; ++m) { const int row = row0 + ai * HALF + m * 16; const float ri = rinv_of(rt, SS, u.pm, row); unsigned ww[4];
#pragma unroll
                    for (int n = 0; n < 2; ++n) { const f32x4 a = acc[ai][0][m][n] * ri, g = acc[ai][1][m][n] * ri; f32x4 hv;
#pragma unroll
                        for (int i = 0; i < 4; ++i) hv[i] = a[i] * sigm(g[i]);
                        ww[2 * n] = cvt_pk_bf16(hv[0], hv[1]); ww[2 * n + 1] = cvt_pk_bf16(hv[2], hv[3]); }
                    u32x4 w; w.x = ww[0]; w.y = ww[1]; w.z = ww[2]; w.w = ww[3];
                    *(u32x4*)(CU + (size_t)row * 256 + col0) = w;
                    if (m & 1) asm volatile("" ::: "memory"); }
        } else {
            if (wc == 0 && fq == 0) {
                const f32x4 b0 = *(const f32x4*)(fb), b1 = *(const f32x4*)(fb + 4);
#pragma unroll
                for (int ai = 0; ai < 2; ++ai)
#pragma unroll
                    for (int m = 0; m < 4; ++m) { const int row = row0 + ai * HALF + m * 16; const float ri = rinv_of(rt, SS, u.pm, row); const int b = row / seq, t = row - b * seq;
#pragma unroll
                        for (int n = 0; n < 2; ++n)
#pragma unroll
                            for (int i = 0; i < 4; ++i) { const float y = acc[ai][0][m][n][i] * ri + (n == 0 ? b0[i] : b1[i]);
                                const float e = __builtin_amdgcn_exp2f(-1.4426950408889634f * __builtin_fabsf(y));
                                const float lf2 = -(__builtin_fmaxf(-y, 0.f) * 1.4426950408889634f + __builtin_amdgcn_logf(1.0f + e));
                                LF2[((size_t)(b * 8 + 4 * n + i)) * seq + t] = lf2; } }
            }
        }
    }
};

template <class Epi, class Sched, bool ALIGN_EPI = false, bool SP2 = false>
__device__ __forceinline__ void gemm_phase(PG8_LAS unsigned char* lds, const Gemm g, const Sched& S, const Epi& E) {
    int tid_ = threadIdx.x; asm volatile("" : "+v"(tid_));
    const int tid = tid_, wid = __builtin_amdgcn_readfirstlane(tid >> 6), lane = tid & 63, wr = wid >> 2, wc = wid & 3, fr = lane & 15, fq = lane >> 4;
    const int K = g.K, nt = K / BK;
    unsigned voffA[2], voffB[2];
#pragma unroll
    for (int i = 0; i < 2; ++i) { int R, C; stage_rc(tid * 16 + i * 8192, R, C); const int Rb = Epi::PERM ? ((R & ~31) + perm32(R & 31)) : R;
        voffA[i] = (unsigned)(R * K + C) * 2u; voffB[i] = (unsigned)(Rb * K + C) * 2u; }
    const size_t kstep = (size_t)(BK * 2);
    const size_t hstep = (size_t)HALF * K * 2;
    const size_t tstep = 2 * hstep;
    const unsigned ldsw = (unsigned)wid * 1024u;
    const int aoff = lds_byte(wr * 64 + fr, fq * 8), boff = lds_byte(wc * 32 + fr, fq * 8);
#define PG8_SA(b, h) (((b) * 2 + (h)) * HTB)
#define PG8_SB(b, h) ((4 + (b) * 2 + (h)) * HTB)
#define PG8_STAGE(bufoff, gbase, voff) do { _Pragma("unroll") for (int _i = 0; _i < 2; ++_i) \
        __builtin_amdgcn_global_load_lds((const unsigned*)((const char*)(gbase) + (voff)[_i]), (PG8_LAS unsigned*)(lds + (bufoff) + ldsw + _i * 8192), 16, 0, 0); } while (0)
#define PG8_LDA(dst, b, h) do { _Pragma("unroll") for (int m = 0; m < 4; ++m) _Pragma("unroll") for (int k = 0; k < 2; ++k) dst[m][k] = *(const PG8_LAS bf16x8*)(lds + PG8_SA(b, h) + aoff + m * 2048 + k * 1024); } while (0)
#define PG8_LDB(dst, b, h) do { _Pragma("unroll") for (int n = 0; n < 2; ++n) _Pragma("unroll") for (int k = 0; k < 2; ++k) dst[n][k] = *(const PG8_LAS bf16x8*)(lds + PG8_SB(b, h) + boff + n * 2048 + k * 1024); } while (0)
#define PG8_MMA(ai, bj, At, Bt) do { __builtin_amdgcn_s_setprio(1); _Pragma("unroll") for (int m = 0; m < 4; ++m) _Pragma("unroll") for (int n = 0; n < 2; ++n) _Pragma("unroll") for (int k = 0; k < 2; ++k) \
        acc[ai][bj][m][n] = __builtin_amdgcn_mfma_f32_16x16x32_bf16(Bt[n][k], At[m][k], acc[ai][bj][m][n], 0, 0, 0); __builtin_amdgcn_s_setprio(0); } while (0)
#define PG8_WAIT_V(n) asm volatile("s_waitcnt vmcnt(" #n ")" ::: "memory")
#define PG8_WAIT_L(n) asm volatile("s_waitcnt lgkmcnt(" #n ")" ::: "memory")
#define PG8_BAR __builtin_amdgcn_s_barrier()
#define PG8_SCHED __builtin_amdgcn_sched_barrier(0)
    Unit cur, nxt; int ui = 0;
    if (!S.next(0, cur)) return;
    f32x4 acc[2][2][4][2];
#pragma unroll
    for (int a = 0; a < 2; ++a)
#pragma unroll
        for (int b = 0; b < 2; ++b)
#pragma unroll
            for (int m = 0; m < 4; ++m)
#pragma unroll
                for (int n = 0; n < 2; ++n) acc[a][b][m][n] = (f32x4){0.f, 0.f, 0.f, 0.f};
    bf16x8 At[4][2], B0[2][2], B1[2][2];
    const char* cA = (const char*)g.A + (size_t)cur.pm * tstep; const char* cB = (const char*)g.Bt + (size_t)cur.pn * tstep;
    S.a_ready(cur);
    if constexpr (SP2) {
        PG8_STAGE(PG8_SB(0, 0), cB, voffB); PG8_STAGE(PG8_SB(0, 1), cB + hstep, voffB); PG8_STAGE(PG8_SA(0, 0), cA, voffA); PG8_STAGE(PG8_SA(0, 1), cA + hstep, voffA);
        if (wr == 1) PG8_BAR;
        PG8_WAIT_V(2); PG8_BAR;
        PG8_STAGE(PG8_SB(1, 0), cB + kstep, voffB); PG8_STAGE(PG8_SA(1, 0), cA + kstep, voffA); PG8_STAGE(PG8_SB(1, 1), cB + hstep + kstep, voffB);
        PG8_WAIT_V(6); PG8_BAR;
    } else {
        PG8_STAGE(PG8_SB(0, 0), cB, voffB); PG8_STAGE(PG8_SA(0, 0), cA, voffA); PG8_STAGE(PG8_SB(0, 1), cB + hstep, voffB); PG8_STAGE(PG8_SA(0, 1), cA + hstep, voffA);
        if (wr == 1) PG8_BAR;
        PG8_WAIT_V(4); PG8_BAR;
        PG8_STAGE(PG8_SB(1, 0), cB + kstep, voffB); PG8_STAGE(PG8_SA(1, 0), cA + kstep, voffA); PG8_STAGE(PG8_SB(1, 1), cB + hstep + kstep, voffB);
        PG8_WAIT_V(6); PG8_BAR;
    }
    for (;;) {
        const bool has_next = S.next(ui + 1, nxt);
        const char* nA = has_next ? (const char*)g.A + (size_t)nxt.pm * tstep : cA; const char* nB = has_next ? (const char*)g.Bt + (size_t)nxt.pn * tstep : cB;
        for (int t = 0; t < nt; t += 2) {
            const bool last = (t == nt - 2);
            const char* a1 = cA + (size_t)(t + 1) * kstep;
            const char* a2 = last ? nA : cA + (size_t)(t + 2) * kstep; const char* b2 = last ? nB : cB + (size_t)(t + 2) * kstep;
            const char* a3 = a2 + kstep; const char* b3 = b2 + kstep;
            if (last && has_next) S.a_ready(nxt);
            if constexpr (SP2) {
            PG8_LDB(B0, 0, 0); PG8_LDB(B1, 0, 1); PG8_SCHED; PG8_LDA(At, 0, 0); PG8_STAGE(PG8_SA(1, 1), a1 + hstep, voffA);
            PG8_WAIT_V(8); PG8_WAIT_L(0); PG8_BAR; PG8_MMA(0, 0, At, B0); PG8_MMA(0, 1, At, B1); PG8_BAR; PG8_SCHED;
            PG8_LDA(At, 0, 1); PG8_STAGE(PG8_SB(0, 0), b2, voffB); PG8_STAGE(PG8_SB(0, 1), b2 + hstep, voffB); PG8_STAGE(PG8_SA(0, 0), a2, voffA);
            PG8_WAIT_V(8); PG8_WAIT_L(0); PG8_BAR; PG8_MMA(1, 0, At, B0); PG8_MMA(1, 1, At, B1); PG8_BAR; PG8_SCHED;
            PG8_LDB(B0, 1, 0); PG8_LDB(B1, 1, 1); PG8_SCHED; PG8_LDA(At, 1, 0); PG8_STAGE(PG8_SA(0, 1), a2 + hstep, voffA);
            PG8_WAIT_V(8); PG8_WAIT_L(0); PG8_BAR; PG8_MMA(0, 0, At, B0); PG8_MMA(0, 1, At, B1); PG8_BAR; PG8_SCHED;
            PG8_LDA(At, 1, 1); PG8_STAGE(PG8_SB(1, 0), b3, voffB); PG8_STAGE(PG8_SB(1, 1), b3 + hstep, voffB); PG8_STAGE(PG8_SA(1, 0), a3, voffA);
            PG8_WAIT_V(8); PG8_WAIT_L(0); PG8_BAR; PG8_MMA(1, 0, At, B0); PG8_MMA(1, 1, At, B1); PG8_BAR; PG8_SCHED;
            } else {
            PG8_LDB(B0, 0, 0); PG8_SCHED; PG8_LDA(At, 0, 0); PG8_STAGE(PG8_SA(1, 1), a1 + hstep, voffA);
            PG8_WAIT_L(8); PG8_BAR; PG8_WAIT_L(0); PG8_MMA(0, 0, At, B0); PG8_BAR; PG8_SCHED;
            PG8_LDB(B1, 0, 1); PG8_STAGE(PG8_SB(0, 0), b2, voffB);
            PG8_BAR; PG8_WAIT_L(0); PG8_MMA(0, 1, At, B1); PG8_BAR;
            PG8_LDA(At, 0, 1); PG8_STAGE(PG8_SA(0, 0), a2, voffA);
            PG8_BAR; PG8_WAIT_L(0); PG8_MMA(1, 0, At, B0); PG8_BAR; PG8_SCHED;
            PG8_STAGE(PG8_SB(0, 1), b2 + hstep, voffB);
            PG8_WAIT_V(6); PG8_BAR; PG8_MMA(1, 1, At, B1); PG8_BAR;
            PG8_LDB(B0, 1, 0); PG8_SCHED; PG8_LDA(At, 1, 0); PG8_STAGE(PG8_SA(0, 1), a2 + hstep, voffA);
            PG8_WAIT_L(8); PG8_BAR; PG8_WAIT_L(0); PG8_MMA(0, 0, At, B0); PG8_BAR; PG8_SCHED;
            PG8_LDB(B1, 1, 1); PG8_STAGE(PG8_SB(1, 0), b3, voffB);
            PG8_BAR; PG8_WAIT_L(0); PG8_MMA(0, 1, At, B1); PG8_BAR;
            PG8_LDA(At, 1, 1); PG8_STAGE(PG8_SA(1, 0), a3, voffA);
            PG8_BAR; PG8_WAIT_L(0); PG8_MMA(1, 0, At, B0); PG8_BAR; PG8_SCHED;
            PG8_STAGE(PG8_SB(1, 1), b3 + hstep, voffB);
            PG8_WAIT_V(6); PG8_BAR; PG8_MMA(1, 1, At, B1); PG8_BAR;
            }
        }
        if constexpr (ALIGN_EPI) { if (wr == 0) PG8_BAR; }
        if constexpr (!Epi::AFTER_DRAIN) { E(acc, cur, wr, wc, fr, fq); S.done(cur); }
        if (!has_next) break;
#pragma unroll
        for (int a = 0; a < 2; ++a)
#pragma unroll
            for (int b = 0; b < 2; ++b)
#pragma unroll
                for (int m = 0; m < 4; ++m)
#pragma unroll
                    for (int n = 0; n < 2; ++n) acc[a][b][m][n] = (f32x4){0.f, 0.f, 0.f, 0.f};
        cur = nxt; cA = nA; cB = nB; ++ui;
        if constexpr (ALIGN_EPI) { if (wr == 1) PG8_BAR; }
    }
    PG8_WAIT_V(0);
    if constexpr (!ALIGN_EPI) { if (wr == 0) PG8_BAR; }
    PG8_BAR;
    if constexpr (Epi::AFTER_DRAIN) { E.fused(acc, cur, wr, wc, fr, fq, lds, wid, lane); S.done(cur); }
#undef PG8_SA
#undef PG8_SB
#undef PG8_STAGE
#undef PG8_LDA
#undef PG8_LDB
#undef PG8_MMA
#undef PG8_WAIT_V
#undef PG8_WAIT_L
#undef PG8_BAR
#undef PG8_SCHED
}
}
namespace attn_body {
using bf16=__hip_bfloat16;
using bf16x8=__attribute__((ext_vector_type(8)))short;
using s16x4=__attribute__((ext_vector_type(4)))short;
using f32x16=__attribute__((ext_vector_type(16)))float;
using f32x4=__attribute__((ext_vector_type(4)))float;
using u32x4=__attribute__((ext_vector_type(4)))unsigned;
constexpr int BATCH=4,NHEAD=8,SEQ=8192,D=64,PQ=NHEAD*D,PO=1024,OCOL=256;
constexpr int NW=8,QBLK=32,QB=QBLK*NW,KVBLK=64,NQB=SEQ/QB;
__device__ __forceinline__ int crow(int r,int hi){return (r&3)+8*(r>>2)+4*hi;}
#define SBAR() __builtin_amdgcn_sched_barrier(0)
__device__ __forceinline__ void cmask(f32x16&p0,f32x16&p1,int jb,int qrel,int hi){
  const float NEG=-INFINITY; int kb=64*jb+4*hi;
  #pragma unroll
  for(int r=0;r<16;++r){int kv=kb+(r&3)+8*(r>>2); if(kv>qrel)p0[r]=NEG; if(kv+32>qrel)p1[r]=NEG;}
}
constexpr int NSLOT=3, SLOTB=8192;
constexpr int LDS_K=0, LDS_V=NSLOT*SLOTB, LDS_WS=2*NSLOT*SLOTB, LDS_OST=LDS_WS+NW*64*4, LDS_FT=LDS_OST+NW*4096, LDS_BYTES=LDS_FT+SEQ*4;
constexpr float C2=0.125f*1.4426950408889634f;
__device__ __forceinline__ void glds16(const void*gsrc,unsigned lds_dst){unsigned keep;
  asm volatile("s_mov_b32 %0, m0\n\ts_mov_b32 m0, %2\n\ts_nop 0\n\tglobal_load_lds_dwordx4 %1, off\n\ts_mov_b32 m0, %0":"=&s"(keep):"v"(gsrc),"s"(lds_dst):"memory");}
__device__ __forceinline__ float max3f(float a,float b,float c){float r;asm("v_max3_f32 %0, %1, %2, %3":"=v"(r):"v"(a),"v"(b),"v"(c));return r;}
__device__ __forceinline__ float max2f(float a,float b){float r;asm("v_max_f32_e32 %0, %1, %2":"=v"(r):"v"(a),"v"(b));return r;}
typedef float f32x2_t __attribute__((ext_vector_type(2))); typedef __bf16 bf16x2_t __attribute__((ext_vector_type(2)));
__device__ __forceinline__ unsigned cvtpk_s(float lo,float hi){f32x2_t v={lo,hi};bf16x2_t b=__builtin_convertvector(v,bf16x2_t);return __builtin_bit_cast(unsigned,b);}
#define WAIT_BAR(N) asm volatile("s_waitcnt vmcnt(" #N ") lgkmcnt(0)\n\ts_barrier":::"memory")
typedef __attribute__((address_space(3))) const char* lds_cptr;
typedef __attribute__((address_space(3))) const float* lds_fptr;
typedef short v4i16_t __attribute__((ext_vector_type(4)));
__device__ __forceinline__ void qkt(f32x16&p0,f32x16&p1,const char*Kslot,const bf16x8*qr,int r32,int hi){
  const char*kb=Kslot+hi*1024+r32*16;
  #pragma unroll
  for(int d0=0;d0<4;++d0){
    const bf16x8 b0=*reinterpret_cast<const bf16x8*>(kb+d0*2048);
    const bf16x8 b1=*reinterpret_cast<const bf16x8*>(kb+d0*2048+512);
    p0=__builtin_amdgcn_mfma_f32_32x32x16_bf16(b0,qr[d0],p0,0,0,0);p1=__builtin_amdgcn_mfma_f32_32x32x16_bf16(b1,qr[d0],p1,0,0,0);}
}
__device__ __forceinline__ void kload8(bf16x8*kf,lds_cptr kp){
  kf[0]=*(const __attribute__((address_space(3))) bf16x8*)(kp);      kf[1]=*(const __attribute__((address_space(3))) bf16x8*)(kp+512);
  kf[2]=*(const __attribute__((address_space(3))) bf16x8*)(kp+2048); kf[3]=*(const __attribute__((address_space(3))) bf16x8*)(kp+2560);
  kf[4]=*(const __attribute__((address_space(3))) bf16x8*)(kp+4096); kf[5]=*(const __attribute__((address_space(3))) bf16x8*)(kp+4608);
  kf[6]=*(const __attribute__((address_space(3))) bf16x8*)(kp+6144); kf[7]=*(const __attribute__((address_space(3))) bf16x8*)(kp+6656);
}
__device__ __forceinline__ void kload2(bf16x8*kf,lds_cptr kp,int j){ kf[2*j]=*(const __attribute__((address_space(3))) bf16x8*)(kp+j*2048); kf[2*j+1]=*(const __attribute__((address_space(3))) bf16x8*)(kp+j*2048+512); }
__device__ __forceinline__ s16x4 vtr(lds_cptr p){ return __builtin_bit_cast(s16x4,__builtin_amdgcn_ds_read_tr16_b64_v4i16((__attribute__((address_space(3))) v4i16_t*)p)); }
__device__ __forceinline__ float rowmax(const f32x16&p0,const f32x16&p1){
  float a=max3f(p0[0],p0[1],p1[0]),b=max3f(p0[2],p0[3],p1[1]);a=max3f(a,p1[2],p1[3]);
  #pragma unroll
  for(int r=4;r<16;r+=4){a=max3f(a,p0[r],p0[r+1]);b=max3f(b,p0[r+2],p0[r+3]);a=max3f(a,p1[r],p1[r+1]);b=max3f(b,p1[r+2],p1[r+3]);}
  const float m=max2f(a,b);
  auto rr=__builtin_amdgcn_permlane32_swap(__float_as_uint(m),__float_as_uint(m),false,false);
  return max2f(__uint_as_float(rr[0]),__uint_as_float(rr[1]));
}
__device__ __forceinline__ void pv(f32x16*o,int vb,bf16x8 pa0,bf16x8 pa1,bf16x8 pa2,bf16x8 pa3){
  #pragma unroll
  for(int d0=0;d0<2;++d0){s16x4 lo[4],hi[4];
    #pragma unroll
    for(int ks=0;ks<4;++ks){
      asm volatile("ds_read_b64_tr_b16 %0,%1 offset:%c2":"=&v"(lo[ks]):"v"(vb),"i"(d0*4096+ks*1024):"memory");
      asm volatile("ds_read_b64_tr_b16 %0,%1 offset:%c2":"=&v"(hi[ks]):"v"(vb),"i"(d0*4096+ks*1024+512):"memory");}
    asm volatile("s_waitcnt lgkmcnt(0)":::"memory");SBAR();
    #define PK(k) (bf16x8){lo[k][0],lo[k][1],lo[k][2],lo[k][3],hi[k][0],hi[k][1],hi[k][2],hi[k][3]}
    o[d0]=__builtin_amdgcn_mfma_f32_32x32x16_bf16(pa0,PK(0),o[d0],0,0,0);
    o[d0]=__builtin_amdgcn_mfma_f32_32x32x16_bf16(pa1,PK(1),o[d0],0,0,0);
    o[d0]=__builtin_amdgcn_mfma_f32_32x32x16_bf16(pa2,PK(2),o[d0],0,0,0);
    o[d0]=__builtin_amdgcn_mfma_f32_32x32x16_bf16(pa3,PK(3),o[d0],0,0,0);
    #undef PK
  }
}
__device__ __forceinline__ void attn_scan(int b,int h,const float*__restrict__ LF2,char*shm){
  int tid_=threadIdx.x; asm volatile("":"+v"(tid_));
  const int tid=tid_,lane=tid&63; const int wid=__builtin_amdgcn_readfirstlane(tid>>6);
  const lds_cptr shm3=(lds_cptr)shm;
  __attribute__((address_space(3))) float* ftw=(__attribute__((address_space(3))) float*)(shm3+LDS_FT);
  __attribute__((address_space(3))) float* wt=(__attribute__((address_space(3))) float*)(shm3+LDS_WS);
  const int t0=tid*16;
  const f32x4* src=(const f32x4*)(LF2+((size_t)(b*NHEAD+h))*SEQ+t0);
  f32x4 v0=src[0],v1=src[1],v2=src[2],v3=src[3];
  v0[1]+=v0[0];v0[2]+=v0[1];v0[3]+=v0[2]; v1[0]+=v0[3];v1[1]+=v1[0];v1[2]+=v1[1];v1[3]+=v1[2];
  v2[0]+=v1[3];v2[1]+=v2[0];v2[2]+=v2[1];v2[3]+=v2[2]; v3[0]+=v2[3];v3[1]+=v3[0];v3[2]+=v3[1];v3[3]+=v3[2];
  const float tot=v3[3]; float x=tot;
  #pragma unroll
  for(int o=1;o<64;o<<=1){const float y=__shfl_up(x,o); if(lane>=o)x+=y;}
  if(lane==63)wt[wid]=x;
  asm volatile("s_waitcnt lgkmcnt(0)\n\ts_barrier":::"memory");
  float woff=0.f;
  #pragma unroll
  for(int w=0;w<NW;++w){const float wv=wt[w]; if(w<wid)woff+=wv;}
  const float add=(x-tot)+woff;
  *(__attribute__((address_space(3))) f32x4*)(ftw+t0)=v0+add; *(__attribute__((address_space(3))) f32x4*)(ftw+t0+4)=v1+add;
  *(__attribute__((address_space(3))) f32x4*)(ftw+t0+8)=v2+add; *(__attribute__((address_space(3))) f32x4*)(ftw+t0+12)=v3+add;
  asm volatile("s_waitcnt lgkmcnt(0)\n\ts_barrier":::"memory");
}
#ifndef ATTN_STORE16
#define ATTN_STORE16(p,v) (*(u32x4*)(p)=(v))
#endif
template<int THRL> __device__ __forceinline__ void attn_unit(int b,int h,int qb,const bf16*Q,const bf16*__restrict__ K,const bf16*__restrict__ V,bf16*O,const float*__restrict__ LF2,const unsigned*KMAX,char*shm){
  int tid_=threadIdx.x; asm volatile("":"+v"(tid_));
  const int tid=tid_,lane=tid&63,r32=lane&31,hi=lane>>5; const int wid=__builtin_amdgcn_readfirstlane(tid>>6);
  const long rowbase=(long)b*SEQ; const int q0=qb*QB;
  const lds_cptr shm3=(lds_cptr)shm;
  const lds_fptr ft=(lds_fptr)(shm3+LDS_FT);
  const bf16*Kh=K+rowbase*PQ+h*D,*Vh=V+rowbase*PQ+h*D;
  const unsigned lds0=(unsigned)(uintptr_t)shm;
  float*wsf=(float*)(shm+LDS_WS)+wid*64;
  const bf16*ksrc=Kh+(long)lane*PQ+wid*8;
  const bf16*vsrc=Vh+(long)(16*(wid&3)+(lane>>2))*PQ+(wid>>2)*32+(lane&3)*8;
  const unsigned kdst=lds0+LDS_K+wid*1024, vdst=lds0+LDS_V+wid*1024;
  const int NTF=(q0+QB)/KVBLK;
  #define DMA_K(t,slot) glds16(ksrc+(long)(NTF-1-(t))*KVBLK*PQ,(unsigned)__builtin_amdgcn_readfirstlane(kdst+(slot)))
  #define DMA_V(t,slot) glds16(vsrc+(long)(NTF-1-(t))*KVBLK*PQ,(unsigned)__builtin_amdgcn_readfirstlane(vdst+(slot)))
  DMA_K(0,0);DMA_V(0,0);DMA_K(1,SLOTB);DMA_K(2,2*SLOTB);
  const bf16*Qw=Q+(rowbase+q0+wid*QBLK)*PQ+h*D;
  bf16x8 qr[4];
  #pragma unroll
  for(int d0=0;d0<4;++d0)qr[d0]=*reinterpret_cast<const bf16x8*>(&Qw[(long)r32*PQ+d0*16+hi*8]);
  float qn2=0.f;
  #pragma unroll
  for(int d0=0;d0<4;++d0)
    #pragma unroll
    for(int e=0;e<8;++e){const float qv=__builtin_bit_cast(float,((unsigned)(unsigned short)qr[d0][e])<<16); qn2+=qv*qv;}
  qn2+=__shfl_xor(qn2,32);
  #pragma unroll
  for(int o=1;o<32;o<<=1)qn2=__builtin_fmaxf(qn2,__shfl_xor(qn2,o));
  { __attribute__((address_space(3))) float* wt=(__attribute__((address_space(3))) float*)(shm3+LDS_WS);
    if(lane==63)wt[8+wid]=qn2;
    asm volatile("s_waitcnt lgkmcnt(0)\n\ts_barrier":::"memory");
  }
  int NT;
  { const __attribute__((address_space(3))) float* wt=(const __attribute__((address_space(3))) float*)(shm3+LDS_WS);
    float qm=wt[8];
    #pragma unroll
    for(int w=1;w<NW;++w)qm=__builtin_fmaxf(qm,wt[8+w]);
    const float km=2.04f*__uint_as_float(__hip_atomic_load(KMAX+b*NHEAD+h,__ATOMIC_RELAXED,__HIP_MEMORY_SCOPE_AGENT));
    const float thr=2.0f*sqrtf(qm*km)+40.0f, fq0=ft[q0];
    const int sc=64*(NTF-(4+2*lane))-1;
    const bool ok=(sc<0)||(ft[sc<0?0:sc]-fq0>=thr);
    const unsigned long long mk=__ballot(ok);
    NT=__builtin_amdgcn_readfirstlane(4+2*(__ffsll((long long)mk)-1)); }
  const int vb0=(int)(lds0+LDS_V)+((lane>>4)&1)*32+(lane&3)*8+(4*hi+((lane&15)>>2))*64;
  const char*Kbase=shm+LDS_K; bf16x8 kf[8];
  const lds_cptr kp0=shm3+LDS_K+hi*1024+r32*16; const lds_cptr vp0=shm3+LDS_V+((lane>>4)&1)*32+(lane&3)*8+(4*hi+((lane&15)>>2))*64;
  const int qrel=wid*QBLK+r32;
  float mhat=-ft[q0+qrel],l_reg=0.f;f32x16 o[2];o[0]=f32x16{};o[1]=f32x16{};
  #define FINIT(P0,P1,t) do{ const lds_fptr fp_=ft+64*(NTF-1-(t))+4*hi; const float nm_=-mhat; \
    _Pragma("unroll") for(int j_=0;j_<4;++j_){ const f32x4 fa_=*(const __attribute__((address_space(3))) f32x4*)(fp_+8*j_); const f32x4 fb_=*(const __attribute__((address_space(3))) f32x4*)(fp_+32+8*j_); \
      _Pragma("unroll") for(int i_=0;i_<4;++i_){P0[4*j_+i_]=nm_-fa_[i_];P1[4*j_+i_]=nm_-fb_[i_];} } }while(0)
  #define CMASK(P0,P1,t) do{int jb_=3-(t); if(jb_>=0)cmask(P0,P1,jb_,qrel,hi);}while(0)
  bool resc=false;
  #define START(P0,P1) do{ const float rm=rowmax(P0,P1); resc=false; \
    { const float dl=__builtin_fmaxf(rm,0.f); mhat+=dl; \
      _Pragma("unroll") for(int r=0;r<16;++r){P0[r]-=dl;P1[r]-=dl;} } \
    _Pragma("unroll") for(int r=0;r<16;++r)P0[r]=__builtin_amdgcn_exp2f(P0[r]); }while(0)
  #define RESC() do{ if(resc){ asm volatile("s_waitcnt lgkmcnt(0)":::"memory"); \
      _Pragma("unroll") for(int d_=0;d_<2;++d_) _Pragma("unroll") for(int r=0;r<16;++r)o[d_][r]*=wsf[crow(r,hi)]; } }while(0)
  f32x16 pA0,pA1,pB0,pB1;
  int sl_prev=0,sl_cur=0,sl_next=SLOTB;
  #define ROT() do{sl_prev=sl_cur;sl_cur=sl_next;sl_next=(sl_next==(NSLOT-1)*SLOTB)?0:sl_next+SLOTB;}while(0)
  FINIT(pA0,pA1,0);
  WAIT_BAR(3);
  qkt(pA0,pA1,Kbase,qr,r32,hi);asm volatile("s_nop 15\n\ts_nop 7":"+v"(pA0),"+v"(pA1));CMASK(pA0,pA1,0);
  START(pA0,pA1);
  _Pragma("unroll") for(int r=0;r<16;++r)pA1[r]=__builtin_amdgcn_exp2f(pA1[r]);
  FINIT(pB0,pB1,1);
  WAIT_BAR(0);
  DMA_K(3,0);DMA_V(1,SLOTB);
  ROT();
  kload8(kf,kp0+sl_cur);
  WAIT_BAR(2);
  s16x4 vlo[8],vhi[8]; u32x4 pw0,pw1,pw2,pw3;
  #define PKW(P,B) cvtpk_s(P[B],P[B+1])
  #define PAF(k) __builtin_bit_cast(bf16x8,pw##k)
  #define VFR(i) (bf16x8){vlo[i][0],vlo[i][1],vlo[i][2],vlo[i][3],vhi[i][0],vhi[i][1],vhi[i][2],vhi[i][3]}
  #define PIN(x) asm volatile("":"+v"(x))
  #define MX3(a,b,c) __builtin_fmaxf(__builtin_fmaxf((a),(b)),(c))
  #define GAPA(MF,A0,A1,A2,A3,W0,W1,PW) do{ MF; sacc+=A0; sacc+=A1; sacc+=A2; sacc+=A3; PIN(sacc); W0; W1; PIN(PW); SBAR(); }while(0)
  #define EX(v) __builtin_amdgcn_exp2f(v)
  #define GAPB(MF,X,B) do{ MF; X[B]=EX(X[B]); X[B+1]=EX(X[B+1]); X[B+2]=EX(X[B+2]); X[B+3]=EX(X[B+3]); PIN(X); SBAR(); }while(0)
  #define VRD(i) do{ vlo[i]=vtr(vp_+(((i)>>2)*4096+((i)&3)*1024)); vhi[i]=vtr(vp_+(((i)>>2)*4096+((i)&3)*1024+512)); }while(0)
  #define KRD(G,j) do{ if(G){ kload2(kf,kp0+sl_next,j); SBAR(); } }while(0)
  #define STEP(C0,C1,P0,P1,t,GK,GV,GL) do{ SBAR(); \
    const lds_cptr vp_=vp0+sl_prev; \
    VRD(0); SBAR(); float sacc=(P0[0]+P0[1]); \
    GAPA(C0=__builtin_amdgcn_mfma_f32_32x32x16_bf16(kf[0],qr[0],C0,0,0,0),   P0[2],P0[3],P0[4],P0[5],     pw0[0]=PKW(P0,0), pw0[1]=PKW(P0,2), pw0); \
    VRD(4); SBAR(); GAPA(C1=__builtin_amdgcn_mfma_f32_32x32x16_bf16(kf[1],qr[0],C1,0,0,0),   P0[6],P0[7],P0[8],P0[9],     pw0[2]=PKW(P0,4), pw0[3]=PKW(P0,6), pw0); \
    VRD(1); SBAR(); GAPA(C0=__builtin_amdgcn_mfma_f32_32x32x16_bf16(kf[2],qr[1],C0,0,0,0),   P0[10],P0[11],P0[12],P0[13], pw1[0]=PKW(P0,8), pw1[1]=PKW(P0,10), pw1); \
    VRD(5); SBAR(); GAPA(C1=__builtin_amdgcn_mfma_f32_32x32x16_bf16(kf[3],qr[1],C1,0,0,0),   P0[14],P0[15],P1[0],P1[1],   pw1[2]=PKW(P0,12),pw1[3]=PKW(P0,14), pw1); \
    VRD(2); SBAR(); GAPA(C0=__builtin_amdgcn_mfma_f32_32x32x16_bf16(kf[4],qr[2],C0,0,0,0),   P1[2],P1[3],P1[4],P1[5],     pw2[0]=PKW(P1,0), pw2[1]=PKW(P1,2), pw2); \
    VRD(6); SBAR(); GAPA(C1=__builtin_amdgcn_mfma_f32_32x32x16_bf16(kf[5],qr[2],C1,0,0,0),   P1[6],P1[7],P1[8],P1[9],     pw2[2]=PKW(P1,4), pw2[3]=PKW(P1,6), pw2); \
    VRD(3); SBAR(); GAPA(C0=__builtin_amdgcn_mfma_f32_32x32x16_bf16(kf[6],qr[3],C0,0,0,0),   P1[10],P1[11],P1[12],P1[13], pw3[0]=PKW(P1,8), pw3[1]=PKW(P1,10), pw3); \
    VRD(7); SBAR(); GAPA(C1=__builtin_amdgcn_mfma_f32_32x32x16_bf16(kf[7],qr[3],C1,0,0,0),   P1[14],P1[15],0.f,0.f,       pw3[2]=PKW(P1,12),pw3[3]=PKW(P1,14), pw3); \
    l_reg+=sacc; \
    if(GK){DMA_K((t)+3,sl_cur);} if(GV){DMA_V((t)+1,sl_next);} \
    CMASK(C0,C1,t); \
    { float a=MX3(C0[0],C0[1],C1[0]),b=MX3(C0[2],C0[3],C1[1]); a=MX3(a,C1[2],C1[3]); \
      _Pragma("unroll") for(int r=4;r<16;r+=4){a=MX3(a,C0[r],C0[r+1]);b=MX3(b,C0[r+2],C0[r+3]);a=MX3(a,C1[r],C1[r+1]);b=MX3(b,C1[r+2],C1[r+3]);} \
      float rm=__builtin_fmaxf(a,b); { auto rr=__builtin_amdgcn_permlane32_swap(__float_as_uint(rm),__float_as_uint(rm),false,false); rm=__builtin_fmaxf(__uint_as_float(rr[0]),__uint_as_float(rr[1])); } \
      resc=false; \
      if(__builtin_expect(__any(rm>(float)THRL),0)){ const float dl=__builtin_fmaxf(rm,0.f); mhat+=dl; \
        _Pragma("unroll") for(int r=0;r<16;++r){C0[r]-=dl;C1[r]-=dl;} \
        const float f=__builtin_amdgcn_exp2f(-dl); l_reg*=f; if(hi==0)wsf[r32]=f; resc=true; } } \
    SBAR(); \
    GAPB(o[0]=__builtin_amdgcn_mfma_f32_32x32x16_bf16(PAF(0),VFR(0),o[0],0,0,0), C0,0); \
    GAPB(o[1]=__builtin_amdgcn_mfma_f32_32x32x16_bf16(PAF(0),VFR(4),o[1],0,0,0), C0,4); \
    KRD(GL,0); GAPB(o[0]=__builtin_amdgcn_mfma_f32_32x32x16_bf16(PAF(1),VFR(1),o[0],0,0,0), C0,8); \
    KRD(GL,1); GAPB(o[1]=__builtin_amdgcn_mfma_f32_32x32x16_bf16(PAF(1),VFR(5),o[1],0,0,0), C0,12); \
    KRD(GL,2); GAPB(o[0]=__builtin_amdgcn_mfma_f32_32x32x16_bf16(PAF(2),VFR(2),o[0],0,0,0), C1,0); \
    KRD(GL,3); GAPB(o[1]=__builtin_amdgcn_mfma_f32_32x32x16_bf16(PAF(2),VFR(6),o[1],0,0,0), C1,4); \
    GAPB(o[0]=__builtin_amdgcn_mfma_f32_32x32x16_bf16(PAF(3),VFR(3),o[0],0,0,0), C1,8); \
    GAPB(o[1]=__builtin_amdgcn_mfma_f32_32x32x16_bf16(PAF(3),VFR(7),o[1],0,0,0), C1,12); \
    if(GL){ FINIT(P0,P1,(t)+1); } \
    }while(0)
  #define ENDW(tt) do{ if((tt)+3<NT){WAIT_BAR(2);} else if((tt)+2<NT){WAIT_BAR(1);} else {WAIT_BAR(0);} }while(0)
  int t=1;
  for(;t<=3&&t+1<NT;t+=2){
    STEP(pB0,pB1,pA0,pA1,t,(t+3<NT),(t+1<NT),(t+1<NT));       ENDW(t);   RESC(); ROT();
    STEP(pA0,pA1,pB0,pB1,t+1,(t+4<NT),(t+2<NT),(t+2<NT));     ENDW(t+1); RESC(); ROT();
  }
  #undef CMASK
  #define CMASK(P0,P1,t) do{}while(0)
  for(;t+5<NT;t+=2){
    STEP(pB0,pB1,pA0,pA1,t,true,true,true);     WAIT_BAR(2); RESC(); ROT();
    STEP(pA0,pA1,pB0,pB1,t+1,true,true,true);   WAIT_BAR(2); RESC(); ROT();
  }
  for(;t+1<NT;t+=2){
    STEP(pB0,pB1,pA0,pA1,t,(t+3<NT),(t+1<NT),(t+1<NT));       ENDW(t);   RESC(); ROT();
    STEP(pA0,pA1,pB0,pB1,t+1,(t+4<NT),(t+2<NT),(t+2<NT));     ENDW(t+1); RESC(); ROT();
  }
  #undef CMASK
  #define CMASK(P0,P1,t) do{int jb_=3-(t); if(jb_>=0)cmask(P0,P1,jb_,qrel,hi);}while(0)
  STEP(pB0,pB1,pA0,pA1,NT-1,false,false,false); RESC();
  { float sacc=pB0[0]+pB0[1]; _Pragma("unroll") for(int r=2;r<16;++r)sacc+=pB0[r]; _Pragma("unroll") for(int r=0;r<16;++r)sacc+=pB1[r]; l_reg+=sacc;
    pw0=(u32x4){PKW(pB0,0),PKW(pB0,2),PKW(pB0,4),PKW(pB0,6)};pw1=(u32x4){PKW(pB0,8),PKW(pB0,10),PKW(pB0,12),PKW(pB0,14)};pw2=(u32x4){PKW(pB1,0),PKW(pB1,2),PKW(pB1,4),PKW(pB1,6)};pw3=(u32x4){PKW(pB1,8),PKW(pB1,10),PKW(pB1,12),PKW(pB1,14)};
    SBAR(); pv(o,vb0+sl_cur,PAF(0),PAF(1),PAF(2),PAF(3)); }
  #undef PKW
  #undef PAF
  #undef VFR
  #undef PIN
  #undef MX3
  #undef GAPA
  #undef GAPB
  #undef EX
  #undef VRD
  #undef KRD
  #undef STEP
  #undef ENDW
  #undef FINIT
  {auto rr=__builtin_amdgcn_permlane32_swap(__float_as_uint(l_reg),__float_as_uint(l_reg),false,false);l_reg=__uint_as_float(rr[0])+__uint_as_float(rr[1]);}
  if(hi==0)wsf[32+r32]=l_reg;asm volatile("s_waitcnt lgkmcnt(0)":::"memory");
  float rli[16];
  #pragma unroll
  for(int r=0;r<16;++r)rli[r]=__builtin_amdgcn_rcpf(wsf[32+crow(r,hi)]);
  bf16*Ow=O+(rowbase+q0+wid*QBLK)*PO+OCOL+h*D;
  { bf16*stg=(bf16*)(shm+LDS_OST)+wid*2048;
    #pragma unroll
    for(int r=0;r<16;++r){const int orow=crow(r,hi);
      #pragma unroll
      for(int d0=0;d0<2;++d0)stg[orow*64+d0*32+r32]=__float2bfloat16(o[d0][r]*rli[r]);}
    asm volatile("s_waitcnt lgkmcnt(0)":::"memory");
    #pragma unroll
    for(int i=0;i<4;++i){const int row=i*8+(lane>>3),ch=lane&7; const u32x4 v=*(const u32x4*)(stg+row*64+ch*8); ATTN_STORE16(Ow+(long)row*PO+ch*8,v);} }
  asm volatile("s_waitcnt lgkmcnt(0)\n\ts_barrier":::"memory");
  #undef DMA_K
  #undef DMA_V
  #undef CMASK
  #undef START
  #undef RESC
  #undef ROT
}
constexpr int ATTN_LDS_BYTES=LDS_BYTES;
#undef SBAR
#undef WAIT_BAR
}
constexpr int NWAVES = 8;
#ifndef MK_PER_PHASE
#define MK_PER_PHASE 0
#endif
#ifndef MK_USE_CG
#define MK_USE_CG 0
#endif
constexpr int BATCH = 4, SEQ = 8192, D = 1024, FF = 2816, DEPTH = 2, NH = 8;
constexpr int M = BATCH * SEQ;
constexpr int NGU = 2 * FF;
constexpr int NWIN = 2560;
constexpr int IN_COLS = 2312;
constexpr size_t MiB = 1u << 20;
constexpr size_t WS_CTL = 0, CTL_ZERO_BYTES = 64 * 1024;
constexpr size_t WS_SS = 1 * MiB;
constexpr size_t WS_LF = 3 * MiB;
constexpr size_t WS_W = 4 * MiB, W_LAYER = 40 * MiB;
constexpr size_t W_GU1 = 0, W_D1 = 11 * MiB, W_WIN = 16 * MiB + 512 * 1024, W_WOUT = 21 * MiB + 512 * 1024, W_GU2 = 23 * MiB + 512 * 1024, W_D2 = 34 * MiB + 512 * 1024;
constexpr size_t WS_XB = 84 * MiB;
constexpr size_t WS_R = 148 * MiB;
constexpr size_t WS_UP = WS_R, WS_Q = WS_R + 16 * MiB, WS_K = WS_R + 48 * MiB, WS_V = WS_R + 80 * MiB, WS_CU = WS_R + 112 * MiB, WS_Y = WS_R + 128 * MiB;
constexpr size_t WS_END = WS_R + 192 * MiB;
static_assert((size_t)M * FF * 2 <= 192 * MiB && (size_t)NGU * D * 2 == 11 * MiB && (size_t)D * FF * 2 == 5 * MiB + 512 * 1024 && (size_t)NWIN * D * 2 == 5 * MiB, "d_ws map");
constexpr int CW_KMAX = 256;
constexpr int CW_BAR = 1024;
constexpr int RING_OFF = 0, RING_BYTES = 131072;
constexpr int LDSCTL_OFF = RING_BYTES, MISC_OFF = LDSCTL_OFF + 320;
constexpr int LDS_BYTES = 147456;
static_assert(attn_body::ATTN_LDS_BYTES <= RING_BYTES && pg8::STAGE_BYTES <= RING_BYTES, "LDS map");

#define GAS __attribute__((address_space(1)))
#define LAS __attribute__((address_space(3)))
typedef unsigned short bf16;
typedef unsigned v4u __attribute__((ext_vector_type(4)));
typedef unsigned v2u __attribute__((ext_vector_type(2)));
typedef float f32x4 __attribute__((ext_vector_type(4)));
#define RLX_AGENT __ATOMIC_RELAXED, __HIP_MEMORY_SCOPE_AGENT
#define LDS_WAIT() asm volatile("s_waitcnt lgkmcnt(0)" ::: "memory")
__device__ __forceinline__ unsigned f2bf(float f) { unsigned u = __builtin_bit_cast(unsigned, f); return (u + 0x7fffu + ((u >> 16) & 1u)) >> 16; }
__device__ __forceinline__ unsigned pk2(float lo, float hi) { return pg8::cvt_pk_bf16(lo, hi); }
__device__ __forceinline__ float bflo(unsigned w) { return __builtin_bit_cast(float, w << 16); }
__device__ __forceinline__ float bfhi(unsigned w) { return __builtin_bit_cast(float, w & 0xffff0000u); }
template <int CTRL> __device__ __forceinline__ float dpp_mov(float x) { return __builtin_bit_cast(float, __builtin_amdgcn_update_dpp(0, __builtin_bit_cast(int, x), CTRL, 0xf, 0xf, false)); }
__device__ __forceinline__ float wave_sum(float x) {
    x += dpp_mov<0x128>(x); x += dpp_mov<0x124>(x); x += dpp_mov<0x122>(x); x += dpp_mov<0x121>(x);
    const int xi = __builtin_bit_cast(int, x);
    const float r0 = __builtin_bit_cast(float, __builtin_amdgcn_readlane(xi, 0)), r1 = __builtin_bit_cast(float, __builtin_amdgcn_readlane(xi, 16));
    const float r2 = __builtin_bit_cast(float, __builtin_amdgcn_readlane(xi, 32)), r3 = __builtin_bit_cast(float, __builtin_amdgcn_readlane(xi, 48));
    return (r0 + r1) + (r2 + r3);
}
#define XB_TMO      128
#define XB_XCNT(j)  (256  + 64 * (j))
#define XB_XSUB(j)  (1280 + 64 * (j))
#define XB_XGEN(j)  (2304 + 64 * (j))
#define XB_TOP      3328
#define XB_TOPGEN   3392
#define XCD_BAR_WORDS 3456
#define XB_SPIN_CAP (1u << 18)

__device__ __forceinline__ unsigned xb_ld(unsigned* p)              { return __hip_atomic_load(p, __ATOMIC_RELAXED, __HIP_MEMORY_SCOPE_AGENT); }
__device__ __forceinline__ unsigned xb_add(unsigned* p, unsigned v) { return __hip_atomic_fetch_add(p, v, __ATOMIC_RELAXED, __HIP_MEMORY_SCOPE_AGENT); }
__device__ __forceinline__ unsigned xb_xcc_id() { return (unsigned)__builtin_amdgcn_s_getreg((3 << 11) | 20) & 0xFu; }
#define XB_SPIN(cond, bar) do { unsigned _sp = 0; while (cond) { __builtin_amdgcn_s_sleep(1); \
    if ((++_sp & 255u) == 0u) { if (xb_ld(&(bar)[XB_TMO])) break; if (_sp > XB_SPIN_CAP) { atomicAdd(&(bar)[XB_TMO], 1u); break; } } } } while (0)

struct XcdBarrier {
    unsigned* bar; unsigned x;
    volatile LAS unsigned* st;
};

__device__ __forceinline__ XcdBarrier xcd_barrier_post(unsigned* bar, volatile LAS unsigned* st) {
    XcdBarrier b; b.bar = bar; b.x = xb_xcc_id(); b.st = st;
    if (threadIdx.x == 0) (void)xb_add(&bar[XB_XCNT(b.x)], 1u);
    return b;
}
__device__ __forceinline__ void xcd_barrier_complete(unsigned* bar, unsigned x, unsigned& nloc, unsigned& nx) {
    const unsigned G = gridDim.x * gridDim.y * gridDim.z;
    unsigned sum, cnt, mine, sp = 0u;
    for (;;) {
        sum = 0u; cnt = 0u; mine = 0u;
#pragma unroll
        for (unsigned j = 0; j < 16; ++j) { const unsigned c = xb_ld(&bar[XB_XCNT(j)]); sum += c; cnt += (c > 0u) ? 1u : 0u; mine = (j == x) ? c : mine; }
        if (sum == G) break;
        __builtin_amdgcn_s_sleep(1);
        if ((++sp & 255u) == 0u) { if (xb_ld(&bar[XB_TMO])) break; if (sp > XB_SPIN_CAP) { atomicAdd(&bar[XB_TMO], 1u); break; } }
    }
    nloc = mine > 0u ? mine : 1u; nx = cnt > 0u ? cnt : 1u;
}

__device__ __forceinline__ void xcd_barrier(const XcdBarrier& b) {
    asm volatile("s_waitcnt vmcnt(0)" ::: "memory");
    __syncthreads();
    if (threadIdx.x == 0) {
        unsigned* bar = b.bar;
        __builtin_amdgcn_s_waitcnt(0);
        unsigned nloc = b.st[0], nx = b.st[1];
        if (nloc == 0u) { xcd_barrier_complete(bar, b.x, nloc, nx); b.st[0] = nloc; b.st[1] = nx; }
        const unsigned old = xb_add(&bar[XB_XSUB(b.x)], 1u);
        const unsigned gen = old / nloc;
        if (old + 1u == (gen + 1u) * nloc) {
            __builtin_amdgcn_fence(__ATOMIC_RELEASE, "agent");
            asm volatile("s_waitcnt vmcnt(0)" ::: "memory");
            const unsigned og = xb_add(&bar[XB_TOP], 1u);
            const unsigned tg = og / nx;
            if (og + 1u == (tg + 1u) * nx) xb_add(&bar[XB_TOPGEN], 1u);
            else XB_SPIN(xb_ld(&bar[XB_TOPGEN]) == tg, bar);
            __builtin_amdgcn_fence(__ATOMIC_ACQUIRE, "agent");
            xb_add(&bar[XB_XGEN(b.x)], 1u);
            asm volatile("s_waitcnt vmcnt(0)" ::: "memory");
        } else {
            XB_SPIN(xb_ld(&bar[XB_XGEN(b.x)]) == gen, bar);
            __builtin_amdgcn_fence(__ATOMIC_ACQUIRE, "agent");
            asm volatile("s_waitcnt vmcnt(0)" ::: "memory");
        }
    }
    __syncthreads();
}
__device__ __forceinline__ void tr_item(const float* W, int N, int col0, int ncols, int k0, const float* gain, bf16* WT, int K, int drow0, LAS float* scr, int lane) {
    const int c = lane & 31; float tv[32];
    const float* wp = W + (size_t)(k0 + (lane >> 5)) * N + col0 + (c < ncols ? c : 0); const float gsel = (c < ncols) ? 1.f : 0.f;
#pragma unroll
    for (int i = 0; i < 32; ++i) tv[i] = wp[(size_t)(2 * i) * N];
    if (gain) {
#pragma unroll
        for (int i = 0; i < 32; ++i) tv[i] *= gain[k0 + 2 * i + (lane >> 5)]; }
#pragma unroll
    for (int i = 0; i < 32; ++i) scr[(2 * i + (lane >> 5)) * 33 + c] = tv[i] * gsel;
    LDS_WAIT(); asm volatile("" ::: "memory");
    const int c8 = lane & 7;
#pragma unroll
    for (int j = 0; j < 4; ++j) { const int n = (lane >> 3) + 8 * j; const LAS float* s = scr + (8 * c8) * 33 + n;
        v4u o; o.x = pk2(s[0 * 33], s[1 * 33]); o.y = pk2(s[2 * 33], s[3 * 33]); o.z = pk2(s[4 * 33], s[5 * 33]); o.w = pk2(s[6 * 33], s[7 * 33]);
        *(GAS v4u*)(WT + (size_t)(drow0 + n) * K + k0 + 8 * c8) = o; }
    LDS_WAIT(); asm volatile("" ::: "memory");
}
struct Args { const float* in[20]; float* out; unsigned char* ws; int ph_lo, ph_hi; };
#define PIn Args
__device__ __forceinline__ void p0_prologue(const PIn& P, unsigned char* ws, LAS unsigned char* lds, int vcu, int G, int wave, int lane) {
    { int t_ = threadIdx.x; asm volatile("" : "+v"(t_)); lane = t_ & 63; wave = __builtin_amdgcn_readfirstlane(t_ >> 6); }
    LAS float* scr = (LAS float*)(lds + RING_OFF + wave * 16384);
    const int gw = vcu * NWAVES + wave, NGW = G * NWAVES;
    constexpr int I_G = (D / 64) * (FF / 32), I_DN = (FF / 64) * (D / 32), I_IN = (D / 64) * 73, I_OUT = 12 * (D / 32);
    constexpr int PER_LAYER = 6 * I_G + I_IN + I_OUT;
    static_assert(I_G == I_DN, "item counts");
    for (int it = gw; it < DEPTH * PER_LAYER; it += NGW) {
        const int l = it / PER_LAYER; int r = it - l * PER_LAYER;
        unsigned char* wl = ws + WS_W + (size_t)l * W_LAYER;
        if (r < 3 * I_G || r >= 3 * I_G + I_IN + I_OUT) {
            const bool second = r >= 3 * I_G; if (second) r -= 3 * I_G + I_IN + I_OUT;
            const int which = r / I_G; r -= which * I_G;
            const float* nrm = (second ? P.in[15] : P.in[1]) + (size_t)l * D;
            if (which < 2) { const float* W = (second ? (which ? P.in[17] : P.in[16]) : (which ? P.in[3] : P.in[2])) + (size_t)l * D * FF; const int kb = r / (FF / 32), nb = r % (FF / 32), n0 = 32 * nb;
                tr_item(W, FF, n0, 32, 64 * kb, nrm, (bf16*)(wl + (second ? W_GU2 : W_GU1)), D, 256 * (n0 >> 7) + (n0 & 127) + 128 * which, scr, lane); }
            else { const float* W = (second ? P.in[18] : P.in[4]) + (size_t)l * FF * D; const int kb = r / (D / 32), nb = r % (D / 32);
                tr_item(W, D, 32 * nb, 32, 64 * kb, nullptr, (bf16*)(wl + (second ? W_D2 : W_D1)), FF, 32 * nb, scr, lane); }
            continue;
        }
        r -= 3 * I_G;
        if (r < I_IN) {
            const float* W = P.in[6] + (size_t)l * D * IN_COLS; const float* nrm = P.in[5] + (size_t)l * D; const int kb = r / 73, nb = r % 73;
            int col0, ncols = 32, drow0;
            if (nb < 56) { col0 = 32 * nb; drow0 = 32 * nb; }
            else if (nb < 64) { const int j = 32 * (nb - 56); col0 = 1800 + j; drow0 = 1792 + 256 * (j >> 7) + (j & 127); }
            else if (nb < 72) { const int j = 32 * (nb - 64); col0 = 2056 + j; drow0 = 1792 + 256 * (j >> 7) + 128 + (j & 127); }
            else { col0 = 1792; ncols = 8; drow0 = 2304; }
            tr_item(W, IN_COLS, col0, ncols, 64 * kb, nrm, (bf16*)(wl + W_WIN), D, drow0, scr, lane);
            continue;
        }
        r -= I_IN;
        { const float* W = P.in[14] + (size_t)l * D * D; const int kb = r / (D / 32), nb = r % (D / 32);
          tr_item(W, D, 32 * nb, 32, 256 + 64 * kb, nullptr, (bf16*)(wl + W_WOUT), D, 32 * nb, scr, lane); }
    }
    { const int gt = gw * 64 + lane, NT_ = NGW * 64;
      for (int e = gt; e < DEPTH * D * 256; e += NT_) { const int l = e / (D * 256), r = e - l * (D * 256), n = r >> 8, k = r & 255, g = k >> 6, c = k & 63;
          const float* pw = P.in[7] + ((size_t)((l * 4 + g) * 64 + c)) * 64; const float* ps = P.in[8] + (size_t)l * 256 + 64 * g; const float* wo = P.in[14] + (size_t)l * D * D + (size_t)(64 * g) * D + n;
          float s = 0.f;
#pragma unroll 8
          for (int d = 0; d < 64; ++d) s += pw[d] * ps[d] * wo[(size_t)d * D];
          ((bf16*)(ws + WS_W + (size_t)l * W_LAYER + W_WOUT))[(size_t)n * D + k] = (bf16)f2bf(s); } }
    { const float* x = P.in[0]; bf16* XB = (bf16*)(ws + WS_XB); float* SS = (float*)(ws + WS_SS);
      for (int m0 = gw * 4; m0 < M; m0 += NGW * 4) { f32x4 v[4][4];
#pragma unroll
          for (int q = 0; q < 4; ++q) { const GAS f32x4* xr = (const GAS f32x4*)(x + (size_t)(m0 + q) * D) + lane;
#pragma unroll
              for (int j = 0; j < 4; ++j) v[q][j] = xr[64 * j]; }
#pragma unroll
          for (int q = 0; q < 4; ++q) { const int m = m0 + q; float s = 0.f;
#pragma unroll
              for (int j = 0; j < 4; ++j) s += (v[q][j].x * v[q][j].x + v[q][j].y * v[q][j].y) + (v[q][j].z * v[q][j].z + v[q][j].w * v[q][j].w);
              s = wave_sum(s);
              GAS unsigned long long* o8 = (GAS unsigned long long*)(XB + (size_t)m * D) + lane;
#pragma unroll
              for (int j = 0; j < 4; ++j) o8[64 * j] = (unsigned long long)pk2(v[q][j].x, v[q][j].y) | ((unsigned long long)pk2(v[q][j].z, v[q][j].w) << 32);
              if (lane < 16) SS[(size_t)m * 16 + lane] = lane == 0 ? s : 0.f; } } }
}
__device__ __forceinline__ f32x4 unpk4(v2u v) { return (f32x4){bflo(v.x), bfhi(v.x), bflo(v.y), bfhi(v.y)}; }
__device__ __forceinline__ void mix_local(LAS unsigned char* lds, int vcu, int G, const bf16* UP, const bf16* CU, bf16* Y, const float* cw, const float* cb, const float* lg, const float* lb) {
    int t_ = threadIdx.x; asm volatile("" : "+v"(t_)); const int lane = t_ & 63, wave = __builtin_amdgcn_readfirstlane(t_ >> 6);
    LAS float* wl = (LAS float*)(lds + RING_OFF);
    { f32x4 tv[4];
#pragma unroll
      for (int q = 0; q < 4; ++q) { const int i = wave * 64 + lane + q * NWAVES * 64; tv[q] = *((const f32x4*)cw + (i < 1984 ? i : 0)); }
#pragma unroll
      for (int q = 0; q < 4; ++q) { const int i = wave * 64 + lane + q * NWAVES * 64; if (i < 1984) *((LAS f32x4*)wl + i) = tv[q]; } }
    __syncthreads();
    const int grp = lane >> 4, wwin = 2 << grp; const unsigned lane8 = 8u * (unsigned)lane;
#pragma unroll 1
    for (int un = vcu * NWAVES + wave; un < M / 16; un += G * NWAVES) {
        const int row0 = un * 16, t0 = row0 & (SEQ - 1);
        v2u pr[31], cr[46];
#pragma unroll
        for (int k = 0; k < 31; ++k) { const bool in = t0 - 15 + k >= 0; const unsigned msk = in ? 0xffffffffu : 0u; const bf16* rp = UP + (size_t)(in ? row0 - 15 + k : row0) * 256; pr[k] = *(const GAS v2u*)((const GAS char*)rp + lane8); pr[k].x &= msk; pr[k].y &= msk; }
#pragma unroll
        for (int k = 0; k < 46; ++k) { const bool in = t0 - 30 + k >= 0; const unsigned msk = in ? 0xffffffffu : 0u; const bf16* rp = CU + (size_t)(in ? row0 - 30 + k : row0) * 256; cr[k] = *(const GAS v2u*)((const GAS char*)rp + lane8); cr[k].x &= msk; cr[k].y &= msk; }
        __builtin_amdgcn_sched_barrier(0);
        {
            f32x4 S = {0.f, 0.f, 0.f, 0.f};
#pragma unroll
            for (int k = 0; k < 16; ++k) { const f32x4 f = unpk4(pr[15 - k]); if (k < wwin) S += f; }
#pragma unroll
            for (int i = 0; i < 16; ++i) {
                const f32x4 cur = unpk4(pr[15 + i]);
                if (i > 0) { const v2u o = (grp == 0) ? pr[15 + i - 2] : (grp == 1) ? pr[15 + i - 4] : (grp == 2) ? pr[15 + i - 8] : pr[15 + i - 16]; S += cur - unpk4(o); }
                const int t = t0 + i, cnt = (t + 1 < wwin) ? t + 1 : wwin;
                const f32x4 p = S * __builtin_amdgcn_rcpf((float)cnt) - cur;
                v2u o2; o2.x = pg8::cvt_pk_bf16(p[0], p[1]); o2.y = pg8::cvt_pk_bf16(p[2], p[3]); *(GAS v2u*)(Y + (size_t)(row0 + i) * D + 4 * lane) = o2;
            }
        }
        __builtin_amdgcn_sched_barrier(0);
        const f32x4 cb4 = *(const f32x4*)(cb + 4 * lane), g4 = *(const f32x4*)(lg + 4 * lane), b4 = *(const f32x4*)(lb + 4 * lane);
#pragma unroll 1
        for (int gi = 0; gi < 2; ++gi) {
            f32x4 acc[8];
#pragma unroll
            for (int i = 0; i < 8; ++i) acc[i] = cb4;
#pragma unroll
            for (int hf = 0; hf < 2; ++hf) {
                constexpr int JN[2] = {16, 15}; const int jlo = 16 * hf;
                f32x4 wv[16];
#pragma unroll
                for (int j = 0; j < 16; ++j) if (j < JN[hf]) wv[j] = *(const LAS f32x4*)(wl + (jlo + j) * 256 + 4 * lane);
#pragma unroll
                for (int rr = 0; rr < 23; ++rr) if (rr < JN[hf] + 7) {
                    const f32x4 f = unpk4(cr[jlo + rr]);
#pragma unroll
                    for (int i = 0; i < 8; ++i) { const int j = rr - i; if (j >= 0 && j < JN[hf]) acc[i] += wv[j] * f; } }
                __builtin_amdgcn_sched_barrier(0);
            }
#pragma unroll
            for (int i = 0; i < 8; ++i) { const f32x4 a = acc[i];
                const float mean = wave_sum((a[0] + a[1]) + (a[2] + a[3])) * (1.0f / 256.0f); const f32x4 d = a - mean;
                const float var = wave_sum((d[0] * d[0] + d[1] * d[1]) + (d[2] * d[2] + d[3] * d[3])) * (1.0f / 256.0f); const float rs = __builtin_amdgcn_rsqf(var + 1e-6f);
                const f32x4 yn = d * rs * g4 + b4; f32x4 o4;
#pragma unroll
                for (int q = 0; q < 4; ++q) o4[q] = yn[q] * pg8::sigm(yn[q]);
                v2u o; o.x = pg8::cvt_pk_bf16(o4[0], o4[1]); o.y = pg8::cvt_pk_bf16(o4[2], o4[3]); *(GAS v2u*)(Y + (size_t)(row0 + 8 * gi + i) * D + 768 + 4 * lane) = o; }
#pragma unroll
            for (int k = 0; k < 38; ++k) cr[k] = cr[k + 8];
            __builtin_amdgcn_sched_barrier(0);
        }
    }
    __syncthreads();
}
__device__ __forceinline__ void final_norm(float* X, const bf16* XB, const float* SS, const float* g, int vcu, int G, int wave, int lane) {
    { int t_ = threadIdx.x; asm volatile("" : "+v"(t_)); lane = t_ & 63; wave = __builtin_amdgcn_readfirstlane(t_ >> 6); }
    const int gw = vcu * NWAVES + wave, NGW = G * NWAVES;
    f32x4 gv[4];
#pragma unroll
    for (int j = 0; j < 4; ++j) gv[j] = *((const f32x4*)g + lane + 64 * j);
    for (int m0 = gw * 2; m0 < M; m0 += NGW * 2) {
        v2u v[2][4]; float ri[2];
#pragma unroll
        for (int q = 0; q < 2; ++q) { const GAS v2u* xr = (const GAS v2u*)(XB + (size_t)(m0 + q) * D) + lane;
#pragma unroll
            for (int j = 0; j < 4; ++j) v[q][j] = xr[64 * j]; ri[q] = pg8::row_rinv(SS, m0 + q); }
#pragma unroll
        for (int q = 0; q < 2; ++q) { GAS f32x4* orow = (GAS f32x4*)(X + (size_t)(m0 + q) * D) + lane;
#pragma unroll
            for (int j = 0; j < 4; ++j) orow[64 * j] = unpk4(v[q][j]) * ri[q] * gv[j]; } }
}

constexpr int RT_OFF = LDSCTL_OFF + 1024;
static_assert(RT_OFF + 4096 <= LDS_BYTES, "LDS map");
__device__ __forceinline__ const LAS float* fill_rinv(LAS unsigned char* lds, const pg8::StaticOrder& S, const float* SS) {
    int tid_ = threadIdx.x; asm volatile("" : "+v"(tid_));
    LAS float* rt = (LAS float*)(lds + RT_OFF);
    pg8::Unit u; int sp0 = -1, sp1 = -1, sp2 = -1, sp3 = -1; bool ok = true;
    for (int i = 0; S.next(i, u); ++i) { const int sl = (u.pm >> 3) & 3; const int cur = sl == 0 ? sp0 : sl == 1 ? sp1 : sl == 2 ? sp2 : sp3;
        if (cur != u.pm) { if (cur != -1) ok = false;
            if (sl == 0) sp0 = u.pm; else if (sl == 1) sp1 = u.pm; else if (sl == 2) sp2 = u.pm; else sp3 = u.pm;
            if (tid_ < 256) rt[sl * 256 + tid_] = pg8::row_rinv(SS, u.pm * 256 + tid_); } }
    __syncthreads();
    return ok ? (const LAS float*)rt : (const LAS float*)nullptr;
}
constexpr int N_PHASES = 2 + 7 * DEPTH;

__global__ void __launch_bounds__(NWAVES * 64, 2) mk_fwd(Args args) {
    extern __shared__ __attribute__((aligned(16))) unsigned char lds_raw[];
    LAS unsigned char* lds = (LAS unsigned char*)lds_raw;
    volatile LAS unsigned* MISC = (volatile LAS unsigned*)(lds + MISC_OFF);
    const int tid = threadIdx.x, lane = tid & 63, wave = __builtin_amdgcn_readfirstlane(tid >> 6);
    const int G = gridDim.x; const int bx = blockIdx.x; const int vcu = (G % 8 == 0) ? (bx % 8) * (G / 8) + bx / 8 : bx;
    unsigned char* ws = args.ws;
    cg::grid_group grid = cg::this_grid();
    for (int u = tid; u < (LDS_BYTES - LDSCTL_OFF) / 4; u += NWAVES * 64) ((LAS unsigned*)(lds + LDSCTL_OFF))[u] = 0u;
    __syncthreads();
#if !MK_USE_CG
    XcdBarrier bar = xcd_barrier_post((unsigned*)(ws + WS_CTL) + CW_BAR, MISC + 8);
#define GRID_BAR() xcd_barrier(bar)
#else
#define GRID_BAR() grid.sync()
#endif
    const int lo = args.ph_lo, hi = args.ph_hi;
#define IN(k) (lo <= (k) && (k) < hi)
#define SEAM(k) do { if (IN(k) && IN((k) + 1)) GRID_BAR(); } while (0)
    float* X = args.out;
    bf16* XB = (bf16*)(ws + WS_XB); float* SS = (float*)(ws + WS_SS); float* LF2 = (float*)(ws + WS_LF);
    bf16* HB = (bf16*)(ws + WS_R); bf16* UP = (bf16*)(ws + WS_UP); bf16* QB_ = (bf16*)(ws + WS_Q); bf16* KB = (bf16*)(ws + WS_K); bf16* VB = (bf16*)(ws + WS_V);
    bf16* CUB = (bf16*)(ws + WS_CU); bf16* YB = (bf16*)(ws + WS_Y);

    if (IN(0)) {
#ifndef REP_P0
#define REP_P0 1
#endif
        for (int rep_ = 0; rep_ < REP_P0; ++rep_) { p0_prologue(args, ws, lds, vcu, G, wave, lane); __syncthreads(); }
        __syncthreads();
        if (IN(1)) GRID_BAR();
        if (hi < 0) grid.sync();
    }
#pragma unroll 1
    for (int l = 0; l < DEPTH; ++l) {
        const int p0 = 1 + 7 * l;
        unsigned char* wl = ws + WS_W + (size_t)l * W_LAYER;
#pragma unroll 1
        for (int f = 0; f < 2; ++f) {
            const int pa = p0 + 5 * f;
            if (IN(pa)) {
                pg8::Gemm g{XB, (const bf16*)(wl + (f ? W_GU2 : W_GU1)), M, NGU, D}; pg8::StaticOrder S; S.init(M, NGU, G, bx);
                pg8::EpiGLU E{HB, FF, SS, fill_rinv(lds, S, SS)};
#ifndef REP_GLU
#define REP_GLU 1
#endif
                for (int rep_ = 0; rep_ < REP_GLU; ++rep_) pg8::gemm_phase<pg8::EpiGLU, pg8::StaticOrder, true, true>(lds + RING_OFF, g, S, E);
            }
            SEAM(pa);
            if (IN(pa + 1)) {
                pg8::Gemm g{HB, (const bf16*)(wl + (f ? W_D2 : W_D1)), M, D, FF}; pg8::StaticOrder S; S.init(M, D, G, bx);
                { pg8::EpiRes<false, false> E{nullptr, nullptr, XB, SS, 0.5f}; pg8::gemm_phase<pg8::EpiRes<false, false>, pg8::StaticOrder, true, true>(lds + RING_OFF, g, S, E); }
            }
            SEAM(pa + 1);
            if (f == 0) {
                if (IN(p0 + 2)) {
                    pg8::Gemm g{XB, (const bf16*)(wl + W_WIN), M, NWIN, D}; pg8::StaticOrder S; S.init(M, NWIN, G, bx);
                    pg8::EpiWin E{UP, QB_, KB, VB, CUB, LF2, SS, args.in[9] + (size_t)l * NH, attn_body::C2, SEQ, (unsigned*)(ws + WS_CTL) + CW_KMAX + 32 * l, fill_rinv(lds, S, SS)};
#ifndef REP_WIN
#define REP_WIN 1
#endif
                    for (int rep_ = 0; rep_ < REP_WIN; ++rep_) pg8::gemm_phase<pg8::EpiWin, pg8::StaticOrder, true, true>(lds + RING_OFF, g, S, E);
                }
                SEAM(p0 + 2);
                if (IN(p0 + 3)) {
#ifndef REP_MIX
#define REP_MIX 1
#endif
                  for (int rep_ = 0; rep_ < REP_MIX; ++rep_) {
#ifndef DIS_MIX
                    mix_local(lds, vcu, G, UP, CUB, YB, args.in[10] + (size_t)l * 31 * 256, args.in[11] + (size_t)l * 256, args.in[12] + (size_t)l * 256, args.in[13] + (size_t)l * 256);
#endif
#ifndef DIS_ATTN
                    for (int v = vcu; v < 256; v += G) { const int bh = v >> 3, s = v & 7;
                        attn_body::attn_scan(bh / NH, bh % NH, LF2, (char*)lds_raw + RING_OFF);
#pragma unroll 1
                        for (int i = 0; i < 4; ++i) { const int qb = (i == 0) ? s : (i == 1) ? 15 - s : (i == 2) ? 16 + s : 31 - s;
                            attn_body::attn_unit<8>(bh / NH, bh % NH, qb, (const attn_body::bf16*)QB_, (const attn_body::bf16*)KB, (const attn_body::bf16*)VB, (attn_body::bf16*)YB, LF2, (const unsigned*)(ws + WS_CTL) + CW_KMAX + 32 * l, (char*)lds_raw + RING_OFF); } }
#endif
                  }
                }
                SEAM(p0 + 3);
                if (IN(p0 + 4)) {
                    pg8::Gemm g{YB, (const bf16*)(wl + W_WOUT), M, D, D}; pg8::StaticOrder S; S.init(M, D, G, bx);
                    pg8::EpiRes<false, false> E{nullptr, nullptr, XB, SS, 1.0f};
                    pg8::gemm_phase<pg8::EpiRes<false, false>, pg8::StaticOrder, true, true>(lds + RING_OFF, g, S, E);
                }
                SEAM(p0 + 4);
            }
        }
    }
    if (IN(N_PHASES - 1)) final_norm(X, XB, SS, args.in[19], vcu, G, wave, lane);
#undef IN
#undef SEAM
}

extern "C" void kernel_launch(void* const* d_in, const int* in_sizes, int n_in, void* d_out, int out_size, void* d_ws, size_t ws_size, hipStream_t stream) {
    static int grid = 0;
    if (grid == 0) {
        if (n_in != 20 || in_sizes[0] != M * D || out_size != M * D || ws_size < WS_END) { fprintf(stderr, "kernel_launch: unexpected shapes (n_in %d, in0 %d, out %d, ws %zu); nothing launched\n", n_in, n_in > 0 ? in_sizes[0] : -1, out_size, ws_size); grid = -1; return; }
        int dev = 0, cus = 0, per_cu = 0;
        if (hipGetDevice(&dev) != hipSuccess || hipDeviceGetAttribute(&cus, hipDeviceAttributeMultiprocessorCount, dev) != hipSuccess) { grid = -1; return; }
        if (hipFuncSetAttribute((const void*)mk_fwd, hipFuncAttributeMaxDynamicSharedMemorySize, LDS_BYTES) != hipSuccess) { fprintf(stderr, "kernel_launch: hipFuncSetAttribute failed\n"); grid = -1; return; }
        if (hipOccupancyMaxActiveBlocksPerMultiprocessor(&per_cu, (const void*)mk_fwd, NWAVES * 64, LDS_BYTES) != hipSuccess || per_cu < 1) per_cu = 1;
        (void)hipGetLastError();
        grid = cus;
    }
    if (grid < 0) return;
    (void)hipMemsetAsync((char*)d_ws + WS_CTL, 0, CTL_ZERO_BYTES, stream);
    Args a{};
    for (int i = 0; i < 20; ++i) a.in[i] = (const float*)d_in[i];
    a.out = (float*)d_out; a.ws = (unsigned char*)d_ws;
#if MK_PER_PHASE
    for (int p = 0; p < N_PHASES; ++p) { a.ph_lo = p; a.ph_hi = p + 1; void* kargs[] = {&a};
        hipError_t e = hipLaunchCooperativeKernel((const void*)mk_fwd, dim3(grid), dim3(NWAVES * 64), kargs, LDS_BYTES, stream);
        if (e != hipSuccess) { fprintf(stderr, "kernel_launch: cooperative launch %d failed: %s\n", p, hipGetErrorString(e)); break; } }
#else
    a.ph_lo = 0; a.ph_hi = N_PHASES; void* kargs[] = {&a};
    hipError_t e = hipLaunchCooperativeKernel((const void*)mk_fwd, dim3(grid), dim3(NWAVES * 64), kargs, LDS_BYTES, stream);
    if (e != hipSuccess) fprintf(stderr, "kernel_launch: cooperative launch failed: %s (grid %d)\n", hipGetErrorString(e), grid);
#endif
}
```

```cpp
#include <hip/hip_runtime.h>
#include <hip/hip_cooperative_groups.h>
#include <hip/hip_bf16.h>
#include <cstdio>
#include <cstdint>
#include <cmath>
namespace cg = cooperative_groups;
namespace pg8 {
#define PG8_LAS __attribute__((address_space(3)))
typedef unsigned short bf16_t;
typedef short bf16x8 __attribute__((ext_vector_type(8)));
typedef float f32x4 __attribute__((ext_vector_type(4)));
typedef unsigned u32x4 __attribute__((ext_vector_type(4)));
constexpr int BM = 256, BK = 64, HALF = 128, HTB = HALF * BK * 2  , STAGE_BYTES = 8 * HTB, NXCD = 8, WGM = 8;

__host__ __device__ __forceinline__ int lds_byte(int r, int c) { const int st = (r >> 4) * 2 + (c >> 5), rr = r & 15, cc = c & 31, ob = rr * 64 + cc * 2; return st * 1024 + (ob ^ (((ob >> 9) & 1) << 5)); }
__host__ __device__ __forceinline__ void stage_rc(int b, int& R, int& C) { const int st = b / 1024, sb = b % 1024, swz = sb ^ (((sb >> 9) & 1) << 5); R = (st >> 1) * 16 + swz / 64; C = (st & 1) * 32 + (swz % 64) / 2; }
__host__ __device__ __forceinline__ int perm32(int rho) { const int n = rho >> 4, i = rho & 15; return 8 * (i >> 2) + 4 * n + (i & 3); }

struct Unit { int pm, pn; };
struct Gemm { const bf16_t* A; const bf16_t* Bt; int M, N, K; };

struct StaticOrder {
    int nM, nN, nwg, G, c;
    __host__ __device__ void init(int M, int N, int G_, int c_) { nM = M / BM; nN = N / BM; nwg = nM * nN; G = G_; c = c_; }
    __host__ __device__ bool next(int i, Unit& u) const {
        const long L = (long)i * G + c; if (L >= nwg) return false;
        int wgid = (int)L; { const int q = nwg / NXCD, r = nwg % NXCD, xcd = wgid % NXCD, off = wgid / NXCD; wgid = (xcd < r ? xcd * (q + 1) : r * (q + 1) + (xcd - r) * q) + off; }
        const int nig = WGM * nN, gid = wgid / nig, fm = gid * WGM, gsz = (nM - fm) < WGM ? (nM - fm) : WGM;
        u.pm = fm + ((wgid % nig) % gsz); u.pn = (wgid % nig) / gsz; return true;
    }
    __device__ __forceinline__ void a_ready(const Unit&) const {}
    __device__ __forceinline__ void done(const Unit&) const {}
};

typedef float f32x2cv __attribute__((ext_vector_type(2))); typedef __bf16 bf16x2cv __attribute__((ext_vector_type(2)));
__device__ __forceinline__ unsigned cvt_pk_bf16(float lo, float hi) { const f32x2cv v = {lo, hi}; return __builtin_bit_cast(unsigned, __builtin_convertvector(v, bf16x2cv)); }
typedef float f32x2 __attribute__((ext_vector_type(2)));
__device__ __forceinline__ float sigm(float x) { return __builtin_amdgcn_rcpf(1.0f + __builtin_amdgcn_exp2f(-1.4426950408889634f * x)); }
__device__ __forceinline__ float row_rinv(const float* SS, int row) {
    const f32x4* p = (const f32x4*)(SS + (size_t)row * 16);
    const f32x4 a = p[0], b = p[1], c = p[2], d = p[3];
    const float s = (((a[0] + a[1]) + (a[2] + a[3])) + ((b[0] + b[1]) + (b[2] + b[3]))) + (((c[0] + c[1]) + (c[2] + c[3])) + ((d[0] + d[1]) + (d[2] + d[3])));
    return __builtin_amdgcn_rsqf(s * (1.0f / 1024.0f) + 1e-6f);
}
__device__ __forceinline__ float rinv_of(const PG8_LAS float* rt, const float* SS, int pm, int row) { return rt ? rt[((pm >> 3) & 3) * 256 + (row & 255)] : row_rinv(SS, row); }
struct EpiGLU {
    static constexpr bool PERM = true, AFTER_DRAIN = false;
    bf16_t* H; int ldh; const float* SS; const PG8_LAS float* rt;
    __device__ __forceinline__ void operator()(const f32x4 (&acc)[2][2][4][2], const Unit& u, int wr, int wc, int fr, int fq) const {
        const int row0 = u.pm * BM + wr * 64 + fr, col0 = u.pn * HALF + wc * 32 + 8 * fq;
#pragma unroll
        for (int ai = 0; ai < 2; ++ai)
#pragma unroll
            for (int m = 0; m < 4; ++m) { const int row = row0 + ai * HALF + m * 16; const float ri = rinv_of(rt, SS, u.pm, row);
                u32x4 w; unsigned ww[4];
#pragma unroll
                for (int n = 0; n < 2; ++n) { const f32x4 g = acc[ai][0][m][n] * ri, up = acc[ai][1][m][n] * ri; const f32x4 t = g * (-1.4426950408889634f); f32x4 e, r;
#pragma unroll
                    for (int i = 0; i < 4; ++i) e[i] = __builtin_amdgcn_exp2f(t[i]);
                    e = e + 1.0f;
#pragma unroll
                    for (int i = 0; i < 4; ++i) r[i] = __builtin_amdgcn_rcpf(e[i]);
                    const f32x4 hv = (g * up) * r;
                    ww[2 * n] = cvt_pk_bf16(hv[0], hv[1]); ww[2 * n + 1] = cvt_pk_bf16(hv[2], hv[3]); }
                w.x = ww[0]; w.y = ww[1]; w.z = ww[2]; w.w = ww[3];
                *(u32x4*)(H + (size_t)row * ldh + col0) = w;
                if (m & 1) asm volatile("" ::: "memory"); }
    }
};
template <bool BASE_F32, bool OUT_F32> struct EpiRes {
    static_assert(!BASE_F32 && !OUT_F32, "bf16 residual stream only");
    static constexpr bool PERM = true, AFTER_DRAIN = false;
    const float* basef; float* outf; bf16_t* xb; float* SS; float scale;
    __device__ __forceinline__ void operator()(const f32x4 (&acc)[2][2][4][2], const Unit& u, int wr, int wc, int fr, int fq) const {
        const int col0 = u.pn * BM + wc * 32 + 8 * fq;
#pragma unroll
        for (int ai = 0; ai < 2; ++ai)
#pragma unroll
            for (int m = 0; m < 4; ++m) { const int row = u.pm * BM + ai * HALF + wr * 64 + m * 16 + fr; bf16_t* rowp = xb + (size_t)row * 1024 + col0; float s = 0.f;
#pragma unroll
                for (int bj = 0; bj < 2; ++bj) { const u32x4 bw = *(const u32x4*)(rowp + bj * HALF);
                    const f32x4 b0 = {__builtin_bit_cast(float, bw.x << 16), __builtin_bit_cast(float, bw.x & 0xffff0000u), __builtin_bit_cast(float, bw.y << 16), __builtin_bit_cast(float, bw.y & 0xffff0000u)};
                    const f32x4 b1 = {__builtin_bit_cast(float, bw.z << 16), __builtin_bit_cast(float, bw.z & 0xffff0000u), __builtin_bit_cast(float, bw.w << 16), __builtin_bit_cast(float, bw.w & 0xffff0000u)};
                    const f32x4 o0 = b0 + acc[ai][bj][m][0] * scale, o1 = b1 + acc[ai][bj][m][1] * scale;
                    u32x4 w; w.x = cvt_pk_bf16(o0[0], o0[1]); w.y = cvt_pk_bf16(o0[2], o0[3]); w.z = cvt_pk_bf16(o1[0], o1[1]); w.w = cvt_pk_bf16(o1[2], o1[3]);
                    *(u32x4*)(rowp + bj * HALF) = w;
                    const f32x4 r0 = {__builtin_bit_cast(float, w.x << 16), __builtin_bit_cast(float, w.x & 0xffff0000u), __builtin_bit_cast(float, w.y << 16), __builtin_bit_cast(float, w.y & 0xffff0000u)};
                    const f32x4 r1 = {__builtin_bit_cast(float, w.z << 16), __builtin_bit_cast(float, w.z & 0xffff0000u), __builtin_bit_cast(float, w.w << 16), __builtin_bit_cast(float, w.w & 0xffff0000u)};
                    s += ((r0[0] * r0[0] + r0[1] * r0[1]) + (r0[2] * r0[2] + r0[3] * r0[3])) + ((r1[0] * r1[0] + r1[1] * r1[1]) + (r1[2] * r1[2] + r1[3] * r1[3])); }
                s += __shfl_xor(s, 16); s += __shfl_xor(s, 32);
                if (fq == 0) SS[(size_t)row * 16 + 4 * u.pn + wc] = s;
                if (m & 1) asm volatile("" ::: "memory"); }
    }
};
struct EpiWin {
    static constexpr bool PERM = true, AFTER_DRAIN = false;
    bf16_t *UP, *Q, *K, *V, *CU; float* LF2; const float* SS; const float* fb; float qscale; int seq; unsigned* kmax; const PG8_LAS float* rt;
    __device__ __forceinline__ void operator()(const f32x4 (&acc)[2][2][4][2], const Unit& u, int wr, int wc, int fr, int fq) const {
        const int pn = u.pn; const int row0 = u.pm * BM + wr * 64 + fr;
        if (pn <= 6) {
            bf16_t* dst; int ld, colt; float sc = 1.f;
            if (pn == 0) { dst = UP; ld = 256; colt = 0; } else if (pn <= 2) { dst = Q; ld = 512; colt = (pn - 1) * 256; sc = qscale; } else if (pn <= 4) { dst = K; ld = 512; colt = (pn - 3) * 256; } else { dst = V; ld = 512; colt = (pn - 5) * 256; }
            const int col0 = colt + wc * 32 + 8 * fq; const bool isk = (pn == 3 || pn == 4); float hm[2] = {0.f, 0.f};
#pragma unroll
            for (int ai = 0; ai < 2; ++ai)
#pragma unroll
                for (int m = 0; m < 4; ++m) { const int row = row0 + ai * HALF + m * 16; const float ri = rinv_of(rt, SS, u.pm, row) * sc; bf16_t* rowp = dst + (size_t)row * ld + col0;
#pragma unroll
                    for (int bj = 0; bj < 2; ++bj) { const f32x4 v0 = acc[ai][bj][m][0] * ri, v1 = acc[ai][bj][m][1] * ri; u32x4 w;
                        w.x = cvt_pk_bf16(v0[0], v0[1]); w.y = cvt_pk_bf16(v0[2], v0[3]); w.z = cvt_pk_bf16(v1[0], v1[1]); w.w = cvt_pk_bf16(v1[2], v1[3]); *(u32x4*)(rowp + bj * HALF) = w;
                        if (isk) { float q = ((v0[0] * v0[0] + v0[1] * v0[1]) + (v0[2] * v0[2] + v0[3] * v0[3])) + ((v1[0] * v1[0] + v1[1] * v1[1]) + (v1[2] * v1[2] + v1[3] * v1[3]));
                            q += __shfl_xor(q, 16); q += __shfl_xor(q, 32); hm[bj] = __builtin_fmaxf(hm[bj], q); } }
                    if (m & 1) asm volatile("" ::: "memory"); }
            if (isk) {
#pragma unroll
                for (int bj = 0; bj < 2; ++bj) { float q = hm[bj];
#pragma unroll
                    for (int o = 1; o < 16; o <<= 1) q = __builtin_fmaxf(q, __shfl_xor(q, o));
                    if (fr == 0 && fq == 0) __hip_atomic_fetch_max(kmax + ((u.pm * BM) / seq) * 8 + (pn - 3) * 4 + 2 * bj + (wc >> 1), __float_as_uint(q), __ATOMIC_RELAXED, __HIP_MEMORY_SCOPE_AGENT); } }
        } else if (pn <= 8) {
            const int col0 = (pn - 7) * HALF + wc * 32 + 8 * fq;
#pragma unroll
            for (int ai = 0; ai < 2; ++ai)
#pragma unroll
                for (int m = 0; m < 4; ++m) { const int row = row0 + ai * HALF + m * 16; const float ri = rinv_of(rt, SS, u.pm, row); unsigned ww[4];
#pragma unroll
                    for (int n = 0; n < 2; ++n) { const f32x4 a = acc[ai][0][m][n] * ri, g = acc[ai][1][m][n] * ri; f32x4 hv;
#pragma unroll
                        for (int i = 0; i < 4; ++i) hv[i] = a[i] * sigm(g[i]);
                        ww[2 * n] = cvt_pk_bf16(hv[0], hv[1]); ww[2 * n + 1] = cvt_pk_bf16(hv[2], hv[3]); }
                    u32x4 w; w.x = ww[0]; w.y = ww[1]; w.z = ww[2]; w.w = ww[3];
                    *(u32x4*)(CU + (size_t)row * 256 + col0) = w;
                    if (m & 1) asm volatile("" ::: "memory"); }
        } else {
            if (wc == 0 && fq == 0) {
                const f32x4 b0 = *(const f32x4*)(fb), b1 = *(const f32x4*)(fb + 4);
#pragma unroll
                for (int ai = 0; ai < 2; ++ai)
#pragma unroll
                    for (int m = 0; m < 4; ++m) { const int row = row0 + ai * HALF + m * 16; const float ri = rinv_of(rt, SS, u.pm, row); const int b = row / seq, t = row - b * seq;
#pragma unroll
                        for (int n = 0; n < 2; ++n)
#pragma unroll
                            for (int i = 0; i < 4; ++i) { const float y = acc[ai][0][m][n][i] * ri + (n == 0 ? b0[i] : b1[i]);
                                const float e = __builtin_amdgcn_exp2f(-1.4426950408889634f * __builtin_fabsf(y));
                                const float lf2 = -(__builtin_fmaxf(-y, 0.f) * 1.4426950408889634f + __builtin_amdgcn_logf(1.0f + e));
                                LF2[((size_t)(b * 8 + 4 * n + i)) * seq + t] = lf2; } }
            }
        }
    }
};

template <class Epi, class Sched, bool ALIGN_EPI = false, bool SP2 = false>
__device__ __forceinline__ void gemm_phase(PG8_LAS unsigned char* lds, const Gemm g, const Sched& S, const Epi& E) {
    int tid_ = threadIdx.x; asm volatile("" : "+v"(tid_));
    const int tid = tid_, wid = __builtin_amdgcn_readfirstlane(tid >> 6), lane = tid & 63, wr = wid >> 2, wc = wid & 3, fr = lane & 15, fq = lane >> 4;
    const int K = g.K, nt = K / BK;
    unsigned voffA[2], voffB[2];
#pragma unroll
    for (int i = 0; i < 2; ++i) { int R, C; stage_rc(tid * 16 + i * 8192, R, C); const int Rb = Epi::PERM ? ((R & ~31) + perm32(R & 31)) : R;
        voffA[i] = (unsigned)(R * K + C) * 2u; voffB[i] = (unsigned)(Rb * K + C) * 2u; }
    const size_t kstep = (size_t)(BK * 2);
    const size_t hstep = (size_t)HALF * K * 2;
    const size_t tstep = 2 * hstep;
    const unsigned ldsw = (unsigned)wid * 1024u;
    const int aoff = lds_byte(wr * 64 + fr, fq * 8), boff = lds_byte(wc * 32 + fr, fq * 8);
#define PG8_SA(b, h) (((b) * 2 + (h)) * HTB)
#define PG8_SB(b, h) ((4 + (b) * 2 + (h)) * HTB)
#define PG8_STAGE(bufoff, gbase, voff) do { _Pragma("unroll") for (int _i = 0; _i < 2; ++_i) \
        __builtin_amdgcn_global_load_lds((const unsigned*)((const char*)(gbase) + (voff)[_i]), (PG8_LAS unsigned*)(lds + (bufoff) + ldsw + _i * 8192), 16, 0, 0); } while (0)
#define PG8_LDA(dst, b, h) do { _Pragma("unroll") for (int m = 0; m < 4; ++m) _Pragma("unroll") for (int k = 0; k < 2; ++k) dst[m][k] = *(const PG8_LAS bf16x8*)(lds + PG8_SA(b, h) + aoff + m * 2048 + k * 1024); } while (0)
#define PG8_LDB(dst, b, h) do { _Pragma("unroll") for (int n = 0; n < 2; ++n) _Pragma("unroll") for (int k = 0; k < 2; ++k) dst[n][k] = *(const PG8_LAS bf16x8*)(lds + PG8_SB(b, h) + boff + n * 2048 + k * 1024); } while (0)
#define PG8_MMA(ai, bj, At, Bt) do { __builtin_amdgcn_s_setprio(1); _Pragma("unroll") for (int m = 0; m < 4; ++m) _Pragma("unroll") for (int n = 0; n < 2; ++n) _Pragma("unroll") for (int k = 0; k < 2; ++k) \
        acc[ai][bj][m][n] = __builtin_amdgcn_mfma_f32_16x16x32_bf16(Bt[n][k], At[m][k], acc[ai][bj][m][n], 0, 0, 0); __builtin_amdgcn_s_setprio(0); } while (0)
#define PG8_WAIT_V(n) asm volatile("s_waitcnt vmcnt(" #n ")" ::: "memory")
#define PG8_WAIT_L(n) asm volatile("s_waitcnt lgkmcnt(" #n ")" ::: "memory")
#define PG8_BAR __builtin_amdgcn_s_barrier()
#define PG8_SCHED __builtin_amdgcn_sched_barrier(0)
    Unit cur, nxt; int ui = 0;
    if (!S.next(0, cur)) return;
    f32x4 acc[2][2][4][2];
#pragma unroll
    for (int a = 0; a < 2; ++a)
#pragma unroll
        for (int b = 0; b < 2; ++b)
#pragma unroll
            for (int m = 0; m < 4; ++m)
#pragma unroll
                for (int n = 0; n < 2; ++n) acc[a][b][m][n] = (f32x4){0.f, 0.f, 0.f, 0.f};
    bf16x8 At[4][2], B0[2][2], B1[2][2];
    const char* cA = (const char*)g.A + (size_t)cur.pm * tstep; const char* cB = (const char*)g.Bt + (size_t)cur.pn * tstep;
    S.a_ready(cur);
    if constexpr (SP2) {
        PG8_STAGE(PG8_SB(0, 0), cB, voffB); PG8_STAGE(PG8_SB(0, 1), cB + hstep, voffB); PG8_STAGE(PG8_SA(0, 0), cA, voffA); PG8_STAGE(PG8_SA(0, 1), cA + hstep, voffA);
        if (wr == 1) PG8_BAR;
        PG8_WAIT_V(2); PG8_BAR;
        PG8_STAGE(PG8_SB(1, 0), cB + kstep, voffB); PG8_STAGE(PG8_SA(1, 0), cA + kstep, voffA); PG8_STAGE(PG8_SB(1, 1), cB + hstep + kstep, voffB);
        PG8_WAIT_V(6); PG8_BAR;
    } else {
        PG8_STAGE(PG8_SB(0, 0), cB, voffB); PG8_STAGE(PG8_SA(0, 0), cA, voffA); PG8_STAGE(PG8_SB(0, 1), cB + hstep, voffB); PG8_STAGE(PG8_SA(0, 1), cA + hstep, voffA);
        if (wr == 1) PG8_BAR;
        PG8_WAIT_V(4); PG8_BAR;
        PG8_STAGE(PG8_SB(1, 0), cB + kstep, voffB); PG8_STAGE(PG8_SA(1, 0), cA + kstep, voffA); PG8_STAGE(PG8_SB(1, 1), cB + hstep + kstep, voffB);
        PG8_WAIT_V(6); PG8_BAR;
    }
    for (;;) {
        const bool has_next = S.next(ui + 1, nxt);
        const char* nA = has_next ? (const char*)g.A + (size_t)nxt.pm * tstep : cA; const char* nB = has_next ? (const char*)g.Bt + (size_t)nxt.pn * tstep : cB;
        for (int t = 0; t < nt; t += 2) {
            const bool last = (t == nt - 2);
            const char* a1 = cA + (size_t)(t + 1) * kstep;
            const char* a2 = last ? nA : cA + (size_t)(t + 2) * kstep; const char* b2 = last ? nB : cB + (size_t)(t + 2) * kstep;
            const char* a3 = a2 + kstep; const char* b3 = b2 + kstep;
            if (last && has_next) S.a_ready(nxt);
            if constexpr (SP2) {
            PG8_LDB(B0, 0, 0); PG8_LDB(B1, 0, 1); PG8_SCHED; PG8_LDA(At, 0, 0); PG8_STAGE(PG8_SA(1, 1), a1 + hstep, voffA);
            PG8_WAIT_V(8); PG8_WAIT_L(0); PG8_BAR; PG8_MMA(0, 0, At, B0); PG8_MMA(0, 1, At, B1); PG8_BAR; PG8_SCHED;
            PG8_LDA(At, 0, 1); PG8_STAGE(PG8_SB(0, 0), b2, voffB); PG8_STAGE(PG8_SB(0, 1), b2 + hstep, voffB); PG8_STAGE(PG8_SA(0, 0), a2, voffA);
            PG8_WAIT_V(8); PG8_WAIT_L(0); PG8_BAR; PG8_MMA(1, 0, At, B0); PG8_MMA(1, 1, At, B1); PG8_BAR; PG8_SCHED;
            PG8_LDB(B0, 1, 0); PG8_LDB(B1, 1, 1); PG8_SCHED; PG8_LDA(At, 1, 0); PG8_STAGE(PG8_SA(0, 1), a2 + hstep, voffA);
            PG8_WAIT_V(8); PG8_WAIT_L(0); PG8_BAR; PG8_MMA(0, 0, At, B0); PG8_MMA(0, 1, At, B1); PG8_BAR; PG8_SCHED;
            PG8_LDA(At, 1, 1); PG8_STAGE(PG8_SB(1, 0), b3, voffB); PG8_STAGE(PG8_SB(1, 1), b3 + hstep, voffB); PG8_STAGE(PG8_SA(1, 0), a3, voffA);
            PG8_WAIT_V(8); PG8_WAIT_L(0); PG8_BAR; PG8_MMA(1, 0, At, B0); PG8_MMA(1, 1, At, B1); PG8_BAR; PG8_SCHED;
            } else {
            PG8_LDB(B0, 0, 0); PG8_SCHED; PG8_LDA(At, 0, 0); PG8_STAGE(PG8_SA(1, 1), a1 + hstep, voffA);
            PG8_WAIT_L(8); PG8_BAR; PG8_WAIT_L(0); PG8_MMA(0, 0, At, B0); PG8_BAR; PG8_SCHED;
            PG8_LDB(B1, 0, 1); PG8_STAGE(PG8_SB(0, 0), b2, voffB);
            PG8_BAR; PG8_WAIT_L(0); PG8_MMA(0, 1, At, B1); PG8_BAR;
            PG8_LDA(At, 0, 1); PG8_STAGE(PG8_SA(0, 0), a2, voffA);
            PG8_BAR; PG8_WAIT_L(0); PG8_MMA(1, 0, At, B0); PG8_BAR; PG8_SCHED;
            PG8_STAGE(PG8_SB(0, 1), b2 + hstep, voffB);
            PG8_WAIT_V(6); PG8_BAR; PG8_MMA(1, 1, At, B1); PG8_BAR;
            PG8_LDB(B0, 1, 0); PG8_SCHED; PG8_LDA(At, 1, 0); PG8_STAGE(PG8_SA(0, 1), a2 + hstep, voffA);
            PG8_WAIT_L(8); PG8_BAR; PG8_WAIT_L(0); PG8_MMA(0, 0, At, B0); PG8_BAR; PG8_SCHED;
            PG8_LDB(B1, 1, 1); PG8_STAGE(PG8_SB(1, 0), b3, voffB);
            PG8_BAR; PG8_WAIT_L(0); PG8_MMA(0, 1, At, B1); PG8_BAR;
            PG8_LDA(At, 1, 1); PG8_STAGE(PG8_SA(1, 0), a3, voffA);
            PG8_BAR; PG8_WAIT_L(0); PG8_MMA(1, 0, At, B0); PG8_BAR; PG8_SCHED;
            PG8_STAGE(PG8_SB(1, 1), b3 + hstep, voffB);
            PG8_WAIT_V(6); PG8_BAR; PG8_MMA(1, 1, At, B1); PG8_BAR;
            }
        }
        if constexpr (ALIGN_EPI) { if (wr == 0) PG8_BAR; }
        if constexpr (!Epi::AFTER_DRAIN) { E(acc, cur, wr, wc, fr, fq); S.done(cur); }
        if (!has_next) break;
#pragma unroll
        for (int a = 0; a < 2; ++a)
#pragma unroll
            for (int b = 0; b < 2; ++b)
#pragma unroll
                for (int m = 0; m < 4; ++m)
#pragma unroll
                    for (int n = 0; n < 2; ++n) acc[a][b][m][n] = (f32x4){0.f, 0.f, 0.f, 0.f};
        cur = nxt; cA = nA; cB = nB; ++ui;
        if constexpr (ALIGN_EPI) { if (wr == 1) PG8_BAR; }
    }
    PG8_WAIT_V(0);
    if constexpr (!ALIGN_EPI) { if (wr == 0) PG8_BAR; }
    PG8_BAR;
    if constexpr (Epi::AFTER_DRAIN) { E.fused(acc, cur, wr, wc, fr, fq, lds, wid, lane); S.done(cur); }
#undef PG8_SA
#undef PG8_SB
#undef PG8_STAGE
#undef PG8_LDA
#undef PG8_LDB
#undef PG8_MMA
#undef PG8_WAIT_V
#undef PG8_WAIT_L
#undef PG8_BAR
#undef PG8_SCHED
}
}
namespace attn_body {
using bf16=__hip_bfloat16;
using bf16x8=__attribute__((ext_vector_type(8)))short;
using s16x4=__attribute__((ext_vector_type(4)))short;
using f32x16=__attribute__((ext_vector_type(16)))float;
using f32x4=__attribute__((ext_vector_type(4)))float;
using u32x4=__attribute__((ext_vector_type(4)))unsigned;
constexpr int BATCH=4,NHEAD=8,SEQ=8192,D=64,PQ=NHEAD*D,PO=1024,OCOL=256;
constexpr int NW=8,QBLK=32,QB=QBLK*NW,KVBLK=64,NQB=SEQ/QB;
__device__ __forceinline__ int crow(int r,int hi){return (r&3)+8*(r>>2)+4*hi;}
#define SBAR() __builtin_amdgcn_sched_barrier(0)
__device__ __forceinline__ void cmask(f32x16&p0,f32x16&p1,int jb,int qrel,int hi){
  const float NEG=-INFINITY; int kb=64*jb+4*hi;
  #pragma unroll
  for(int r=0;r<16;++r){int kv=kb+(r&3)+8*(r>>2); if(kv>qrel)p0[r]=NEG; if(kv+32>qrel)p1[r]=NEG;}
}
constexpr int NSLOT=3, SLOTB=8192;
constexpr int LDS_K=0, LDS_V=NSLOT*SLOTB, LDS_WS=2*NSLOT*SLOTB, LDS_OST=LDS_WS+NW*64*4, LDS_FT=LDS_OST+NW*4096, LDS_BYTES=LDS_FT+SEQ*4;
constexpr float C2=0.125f*1.4426950408889634f;
__device__ __forceinline__ void glds16(const void*gsrc,unsigned lds_dst){unsigned keep;
  asm volatile("s_mov_b32 %0, m0\n\ts_mov_b32 m0, %2\n\ts_nop 0\n\tglobal_load_lds_dwordx4 %1, off\n\ts_mov_b32 m0, %0":"=&s"(keep):"v"(gsrc),"s"(lds_dst):"memory");}
__device__ __forceinline__ float max3f(float a,float b,float c){float r;asm("v_max3_f32 %0, %1, %2, %3":"=v"(r):"v"(a),"v"(b),"v"(c));return r;}
__device__ __forceinline__ float max2f(float a,float b){float r;asm("v_max_f32_e32 %0, %1, %2":"=v"(r):"v"(a),"v"(b));return r;}
typedef float f32x2_t __attribute__((ext_vector_type(2))); typedef __bf16 bf16x2_t __attribute__((ext_vector_type(2)));
__device__ __forceinline__ unsigned cvtpk_s(float lo,float hi){f32x2_t v={lo,hi};bf16x2_t b=__builtin_convertvector(v,bf16x2_t);return __builtin_bit_cast(unsigned,b);}
#define WAIT_BAR(N) asm volatile("s_waitcnt vmcnt(" #N ") lgkmcnt(0)\n\ts_barrier":::"memory")
typedef __attribute__((address_space(3))) const char* lds_cptr;
typedef __attribute__((address_space(3))) const float* lds_fptr;
typedef short v4i16_t __attribute__((ext_vector_type(4)));
__device__ __forceinline__ void qkt(f32x16&p0,f32x16&p1,const char*Kslot,const bf16x8*qr,int r32,int hi){
  const char*kb=Kslot+hi*1024+r32*16;
  #pragma unroll
  for(int d0=0;d0<4;++d0){
    const bf16x8 b0=*reinterpret_cast<const bf16x8*>(kb+d0*2048);
    const bf16x8 b1=*reinterpret_cast<const bf16x8*>(kb+d0*2048+512);
    p0=__builtin_amdgcn_mfma_f32_32x32x16_bf16(b0,qr[d0],p0,0,0,0);p1=__builtin_amdgcn_mfma_f32_32x32x16_bf16(b1,qr[d0],p1,0,0,0);}
}
__device__ __forceinline__ void kload8(bf16x8*kf,lds_cptr kp){
  kf[0]=*(const __attribute__((address_space(3))) bf16x8*)(kp);      kf[1]=*(const __attribute__((address_space(3))) bf16x8*)(kp+512);
  kf[2]=*(const __attribute__((address_space(3))) bf16x8*)(kp+2048); kf[3]=*(const __attribute__((address_space(3))) bf16x8*)(kp+2560);
  kf[4]=*(const __attribute__((address_space(3))) bf16x8*)(kp+4096); kf[5]=*(const __attribute__((address_space(3))) bf16x8*)(kp+4608);
  kf[6]=*(const __attribute__((address_space(3))) bf16x8*)(kp+6144); kf[7]=*(const __attribute__((address_space(3))) bf16x8*)(kp+6656);
}
__device__ __forceinline__ void kload2(bf16x8*kf,lds_cptr kp,int j){ kf[2*j]=*(const __attribute__((address_space(3))) bf16x8*)(kp+j*2048); kf[2*j+1]=*(const __attribute__((address_space(3))) bf16x8*)(kp+j*2048+512); }
__device__ __forceinline__ s16x4 vtr(lds_cptr p){ return __builtin_bit_cast(s16x4,__builtin_amdgcn_ds_read_tr16_b64_v4i16((__attribute__((address_space(3))) v4i16_t*)p)); }
__device__ __forceinline__ float rowmax(const f32x16&p0,const f32x16&p1){
  float a=max3f(p0[0],p0[1],p1[0]),b=max3f(p0[2],p0[3],p1[1]);a=max3f(a,p1[2],p1[3]);
  #pragma unroll
  for(int r=4;r<16;r+=4){a=max3f(a,p0[r],p0[r+1]);b=max3f(b,p0[r+2],p0[r+3]);a=max3f(a,p1[r],p1[r+1]);b=max3f(b,p1[r+2],p1[r+3]);}
  const float m=max2f(a,b);
  auto rr=__builtin_amdgcn_permlane32_swap(__float_as_uint(m),__float_as_uint(m),false,false);
  return max2f(__uint_as_float(rr[0]),__uint_as_float(rr[1]));
}
__device__ __forceinline__ void pv(f32x16*o,int vb,bf16x8 pa0,bf16x8 pa1,bf16x8 pa2,bf16x8 pa3){
  #pragma unroll
  for(int d0=0;d0<2;++d0){s16x4 lo[4],hi[4];
    #pragma unroll
    for(int ks=0;ks<4;++ks){
      asm volatile("ds_read_b64_tr_b16 %0,%1 offset:%c2":"=&v"(lo[ks]):"v"(vb),"i"(d0*4096+ks*1024):"memory");
      asm volatile("ds_read_b64_tr_b16 %0,%1 offset:%c2":"=&v"(hi[ks]):"v"(vb),"i"(d0*4096+ks*1024+512):"memory");}
    asm volatile("s_waitcnt lgkmcnt(0)":::"memory");SBAR();
    #define PK(k) (bf16x8){lo[k][0],lo[k][1],lo[k][2],lo[k][3],hi[k][0],hi[k][1],hi[k][2],hi[k][3]}
    o[d0]=__builtin_amdgcn_mfma_f32_32x32x16_bf16(pa0,PK(0),o[d0],0,0,0);
    o[d0]=__builtin_amdgcn_mfma_f32_32x32x16_bf16(pa1,PK(1),o[d0],0,0,0);
    o[d0]=__builtin_amdgcn_mfma_f32_32x32x16_bf16(pa2,PK(2),o[d0],0,0,0);
    o[d0]=__builtin_amdgcn_mfma_f32_32x32x16_bf16(pa3,PK(3),o[d0],0,0,0);
    #undef PK
  }
}
__device__ __forceinline__ void attn_scan(int b,int h,const float*__restrict__ LF2,char*shm){
  int tid_=threadIdx.x; asm volatile("":"+v"(tid_));
  const int tid=tid_,lane=tid&63; const int wid=__builtin_amdgcn_readfirstlane(tid>>6);
  const lds_cptr shm3=(lds_cptr)shm;
  __attribute__((address_space(3))) float* ftw=(__attribute__((address_space(3))) float*)(shm3+LDS_FT);
  __attribute__((address_space(3))) float* wt=(__attribute__((address_space(3))) float*)(shm3+LDS_WS);
  const int t0=tid*16;
  const f32x4* src=(const f32x4*)(LF2+((size_t)(b*NHEAD+h))*SEQ+t0);
  f32x4 v0=src[0],v1=src[1],v2=src[2],v3=src[3];
  v0[1]+=v0[0];v0[2]+=v0[1];v0[3]+=v0[2]; v1[0]+=v0[3];v1[1]+=v1[0];v1[2]+=v1[1];v1[3]+=v1[2];
  v2[0]+=v1[3];v2[1]+=v2[0];v2[2]+=v2[1];v2[3]+=v2[2]; v3[0]+=v2[3];v3[1]+=v3[0];v3[2]+=v3[1];v3[3]+=v3[2];
  const float tot=v3[3]; float x=tot;
  #pragma unroll
  for(int o=1;o<64;o<<=1){const float y=__shfl_up(x,o); if(lane>=o)x+=y;}
  if(lane==63)wt[wid]=x;
  asm volatile("s_waitcnt lgkmcnt(0)\n\ts_barrier":::"memory");
  float woff=0.f;
  #pragma unroll
  for(int w=0;w<NW;++w){const float wv=wt[w]; if(w<wid)woff+=wv;}
  const float add=(x-tot)+woff;
  *(__attribute__((address_space(3))) f32x4*)(ftw+t0)=v0+add; *(__attribute__((address_space(3))) f32x4*)(ftw+t0+4)=v1+add;
  *(__attribute__((address_space(3))) f32x4*)(ftw+t0+8)=v2+add; *(__attribute__((address_space(3))) f32x4*)(ftw+t0+12)=v3+add;
  asm volatile("s_waitcnt lgkmcnt(0)\n\ts_barrier":::"memory");
}
#ifndef ATTN_STORE16
#define ATTN_STORE16(p,v) (*(u32x4*)(p)=(v))
#endif
template<int THRL> __device__ __forceinline__ void attn_unit(int b,int h,int qb,const bf16*Q,const bf16*__restrict__ K,const bf16*__restrict__ V,bf16*O,const float*__restrict__ LF2,const float km,char*shm){
  int tid_=threadIdx.x; asm volatile("":"+v"(tid_));
  const int tid=tid_,lane=tid&63,r32=lane&31,hi=lane>>5; const int wid=__builtin_amdgcn_readfirstlane(tid>>6);
  const long rowbase=(long)b*SEQ; const int q0=qb*QB;
  const lds_cptr shm3=(lds_cptr)shm;
  const lds_fptr ft=(lds_fptr)(shm3+LDS_FT);
  const bf16*Kh=K+rowbase*PQ+h*D,*Vh=V+rowbase*PQ+h*D;
  const unsigned lds0=(unsigned)(uintptr_t)shm;
  float*wsf=(float*)(shm+LDS_WS)+wid*64;
  const bf16*ksrc=Kh+(long)lane*PQ+wid*8;
  const bf16*vsrc=Vh+(long)(16*(wid&3)+(lane>>2))*PQ+(wid>>2)*32+(lane&3)*8;
  const unsigned kdst=lds0+LDS_K+wid*1024, vdst=lds0+LDS_V+wid*1024;
  const int NTF=(q0+QB)/KVBLK;
  #define DMA_K(t,slot) glds16(ksrc+(long)(NTF-1-(t))*KVBLK*PQ,(unsigned)__builtin_amdgcn_readfirstlane(kdst+(slot)))
  #define DMA_V(t,slot) glds16(vsrc+(long)(NTF-1-(t))*KVBLK*PQ,(unsigned)__builtin_amdgcn_readfirstlane(vdst+(slot)))
  DMA_K(0,0);DMA_V(0,0);DMA_K(1,SLOTB);DMA_K(2,2*SLOTB);
  const bf16*Qw=Q+(rowbase+q0+wid*QBLK)*PQ+h*D;
  bf16x8 qr[4];
  #pragma unroll
  for(int d0=0;d0<4;++d0)qr[d0]=*reinterpret_cast<const bf16x8*>(&Qw[(long)r32*PQ+d0*16+hi*8]);
  float qn2=0.f;
  #pragma unroll
  for(int d0=0;d0<4;++d0)
    #pragma unroll
    for(int e=0;e<8;++e){const float qv=__builtin_bit_cast(float,((unsigned)(unsigned short)qr[d0][e])<<16); qn2+=qv*qv;}
  qn2+=__shfl_xor(qn2,32);
  #pragma unroll
  for(int o=1;o<32;o<<=1)qn2=__builtin_fmaxf(qn2,__shfl_xor(qn2,o));
  { __attribute__((address_space(3))) float* wt=(__attribute__((address_space(3))) float*)(shm3+LDS_WS);
    if(lane==63)wt[8+wid]=qn2;
    asm volatile("s_waitcnt lgkmcnt(0)\n\ts_barrier":::"memory");
  }
  int NT;
  { const __attribute__((address_space(3))) float* wt=(const __attribute__((address_space(3))) float*)(shm3+LDS_WS);
    float qm=wt[8];
    #pragma unroll
    for(int w=1;w<NW;++w)qm=__builtin_fmaxf(qm,wt[8+w]);
    const float thr=2.0f*sqrtf(qm*km)+40.0f, fq0=ft[q0];
    const int sc=64*(NTF-(4+2*lane))-1;
    const bool ok=(sc<0)||(ft[sc<0?0:sc]-fq0>=thr);
    const unsigned long long mk=__ballot(ok);
    NT=__builtin_amdgcn_readfirstlane(4+2*(__ffsll((long long)mk)-1)); }
  const int vb0=(int)(lds0+LDS_V)+((lane>>4)&1)*32+(lane&3)*8+(4*hi+((lane&15)>>2))*64;
  const char*Kbase=shm+LDS_K; bf16x8 kf[8];
  const lds_cptr kp0=shm3+LDS_K+hi*1024+r32*16; const lds_cptr vp0=shm3+LDS_V+((lane>>4)&1)*32+(lane&3)*8+(4*hi+((lane&15)>>2))*64;
  const int qrel=wid*QBLK+r32;
  float mhat=-ft[q0+qrel],l_reg=0.f;f32x16 o[2];o[0]=f32x16{};o[1]=f32x16{};
  #define FINIT(P0,P1,t) do{ const lds_fptr fp_=ft+64*(NTF-1-(t))+4*hi; const float nm_=-mhat; \
    _Pragma("unroll") for(int j_=0;j_<4;++j_){ const f32x4 fa_=*(const __attribute__((address_space(3))) f32x4*)(fp_+8*j_); const f32x4 fb_=*(const __attribute__((address_space(3))) f32x4*)(fp_+32+8*j_); \
      _Pragma("unroll") for(int i_=0;i_<4;++i_){P0[4*j_+i_]=nm_-fa_[i_];P1[4*j_+i_]=nm_-fb_[i_];} } }while(0)
  #define CMASK(P0,P1,t) do{int jb_=3-(t); if(jb_>=0)cmask(P0,P1,jb_,qrel,hi);}while(0)
  bool resc=false;
  #define START(P0,P1) do{ const float rm=rowmax(P0,P1); resc=false; \
    { const float dl=__builtin_fmaxf(rm,0.f); mhat+=dl; \
      _Pragma("unroll") for(int r=0;r<16;++r){P0[r]-=dl;P1[r]-=dl;} } \
    _Pragma("unroll") for(int r=0;r<16;++r)P0[r]=__builtin_amdgcn_exp2f(P0[r]); }while(0)
  #define RESC() do{ if(resc){ asm volatile("s_waitcnt lgkmcnt(0)":::"memory"); \
      _Pragma("unroll") for(int d_=0;d_<2;++d_) _Pragma("unroll") for(int r=0;r<16;++r)o[d_][r]*=wsf[crow(r,hi)]; } }while(0)
  f32x16 pA0,pA1,pB0,pB1;
  int sl_prev=0,sl_cur=0,sl_next=SLOTB;
  #define ROT() do{sl_prev=sl_cur;sl_cur=sl_next;sl_next=(sl_next==(NSLOT-1)*SLOTB)?0:sl_next+SLOTB;}while(0)
  FINIT(pA0,pA1,0);
  WAIT_BAR(3);
  qkt(pA0,pA1,Kbase,qr,r32,hi);asm volatile("s_nop 15\n\ts_nop 7":"+v"(pA0),"+v"(pA1));CMASK(pA0,pA1,0);
  START(pA0,pA1);
  _Pragma("unroll") for(int r=0;r<16;++r)pA1[r]=__builtin_amdgcn_exp2f(pA1[r]);
  FINIT(pB0,pB1,1);
  WAIT_BAR(0);
  DMA_K(3,0);DMA_V(1,SLOTB);
  ROT();
  kload8(kf,kp0+sl_cur);
  WAIT_BAR(2);
  s16x4 vlo[8],vhi[8]; u32x4 pw0,pw1,pw2,pw3;
  #define PKW(P,B) cvtpk_s(P[B],P[B+1])
  #define PAF(k) __builtin_bit_cast(bf16x8,pw##k)
  #define VFR(i) (bf16x8){vlo[i][0],vlo[i][1],vlo[i][2],vlo[i][3],vhi[i][0],vhi[i][1],vhi[i][2],vhi[i][3]}
  #define PIN(x) asm volatile("":"+v"(x))
  #define MX3(a,b,c) __builtin_fmaxf(__builtin_fmaxf((a),(b)),(c))
  #define GAPA(MF,A0,A1,A2,A3,W0,W1,PW) do{ MF; sacc+=A0; sacc+=A1; sacc+=A2; sacc+=A3; PIN(sacc); W0; W1; PIN(PW); SBAR(); }while(0)
  #define EX(v) __builtin_amdgcn_exp2f(v)
  #define GAPB(MF,X,B) do{ MF; X[B]=EX(X[B]); X[B+1]=EX(X[B+1]); X[B+2]=EX(X[B+2]); X[B+3]=EX(X[B+3]); PIN(X); SBAR(); }while(0)
  #define VRD(i) do{ vlo[i]=vtr(vp_+(((i)>>2)*4096+((i)&3)*1024)); vhi[i]=vtr(vp_+(((i)>>2)*4096+((i)&3)*1024+512)); }while(0)
  #define KRD(G,j) do{ if(G){ kload2(kf,kp0+sl_next,j); SBAR(); } }while(0)
  #define STEP(C0,C1,P0,P1,t,GK,GV,GL) do{ SBAR(); \
    const lds_cptr vp_=vp0+sl_prev; \
    VRD(0); SBAR(); float sacc=(P0[0]+P0[1]); \
    GAPA(C0=__builtin_amdgcn_mfma_f32_32x32x16_bf16(kf[0],qr[0],C0,0,0,0),   P0[2],P0[3],P0[4],P0[5],     pw0[0]=PKW(P0,0), pw0[1]=PKW(P0,2), pw0); \
    VRD(4); SBAR(); GAPA(C1=__builtin_amdgcn_mfma_f32_32x32x16_bf16(kf[1],qr[0],C1,0,0,0),   P0[6],P0[7],P0[8],P0[9],     pw0[2]=PKW(P0,4), pw0[3]=PKW(P0,6), pw0); \
    VRD(1); SBAR(); GAPA(C0=__builtin_amdgcn_mfma_f32_32x32x16_bf16(kf[2],qr[1],C0,0,0,0),   P0[10],P0[11],P0[12],P0[13], pw1[0]=PKW(P0,8), pw1[1]=PKW(P0,10), pw1); \
    VRD(5); SBAR(); GAPA(C1=__builtin_amdgcn_mfma_f32_32x32x16_bf16(kf[3],qr[1],C1,0,0,0),   P0[14],P0[15],P1[0],P1[1],   pw1[2]=PKW(P0,12),pw1[3]=PKW(P0,14), pw1); \
    VRD(2); SBAR(); GAPA(C0=__builtin_amdgcn_mfma_f32_32x32x16_bf16(kf[4],qr[2],C0,0,0,0),   P1[2],P1[3],P1[4],P1[5],     pw2[0]=PKW(P1,0), pw2[1]=PKW(P1,2), pw2); \
    VRD(6); SBAR(); GAPA(C1=__builtin_amdgcn_mfma_f32_32x32x16_bf16(kf[5],qr[2],C1,0,0,0),   P1[6],P1[7],P1[8],P1[9],     pw2[2]=PKW(P1,4), pw2[3]=PKW(P1,6), pw2); \
    VRD(3); SBAR(); GAPA(C0=__builtin_amdgcn_mfma_f32_32x32x16_bf16(kf[6],qr[3],C0,0,0,0),   P1[10],P1[11],P1[12],P1[13], pw3[0]=PKW(P1,8), pw3[1]=PKW(P1,10), pw3); \
    VRD(7); SBAR(); GAPA(C1=__builtin_amdgcn_mfma_f32_32x32x16_bf16(kf[7],qr[3],C1,0,0,0),   P1[14],P1[15],0.f,0.f,       pw3[2]=PKW(P1,12),pw3[3]=PKW(P1,14), pw3); \
    l_reg+=sacc; \
    if(GK){DMA_K((t)+3,sl_cur);} if(GV){DMA_V((t)+1,sl_next);} \
    CMASK(C0,C1,t); \
    { float a=MX3(C0[0],C0[1],C1[0]),b=MX3(C0[2],C0[3],C1[1]); a=MX3(a,C1[2],C1[3]); \
      _Pragma("unroll") for(int r=4;r<16;r+=4){a=MX3(a,C0[r],C0[r+1]);b=MX3(b,C0[r+2],C0[r+3]);a=MX3(a,C1[r],C1[r+1]);b=MX3(b,C1[r+2],C1[r+3]);} \
      float rm=__builtin_fmaxf(a,b); { auto rr=__builtin_amdgcn_permlane32_swap(__float_as_uint(rm),__float_as_uint(rm),false,false); rm=__builtin_fmaxf(__uint_as_float(rr[0]),__uint_as_float(rr[1])); } \
      resc=false; \
      if(__builtin_expect(__any(rm>(float)THRL),0)){ const float dl=__builtin_fmaxf(rm,0.f); mhat+=dl; \
        _Pragma("unroll") for(int r=0;r<16;++r){C0[r]-=dl;C1[r]-=dl;} \
        const float f=__builtin_amdgcn_exp2f(-dl); l_reg*=f; if(hi==0)wsf[r32]=f; resc=true; } } \
    SBAR(); \
    GAPB(o[0]=__builtin_amdgcn_mfma_f32_32x32x16_bf16(PAF(0),VFR(0),o[0],0,0,0), C0,0); \
    GAPB(o[1]=__builtin_amdgcn_mfma_f32_32x32x16_bf16(PAF(0),VFR(4),o[1],0,0,0), C0,4); \
    KRD(GL,0); GAPB(o[0]=__builtin_amdgcn_mfma_f32_32x32x16_bf16(PAF(1),VFR(1),o[0],0,0,0), C0,8); \
    KRD(GL,1); GAPB(o[1]=__builtin_amdgcn_mfma_f32_32x32x16_bf16(PAF(1),VFR(5),o[1],0,0,0), C0,12); \
    KRD(GL,2); GAPB(o[0]=__builtin_amdgcn_mfma_f32_32x32x16_bf16(PAF(2),VFR(2),o[0],0,0,0), C1,0); \
    KRD(GL,3); GAPB(o[1]=__builtin_amdgcn_mfma_f32_32x32x16_bf16(PAF(2),VFR(6),o[1],0,0,0), C1,4); \
    GAPB(o[0]=__builtin_amdgcn_mfma_f32_32x32x16_bf16(PAF(3),VFR(3),o[0],0,0,0), C1,8); \
    GAPB(o[1]=__builtin_amdgcn_mfma_f32_32x32x16_bf16(PAF(3),VFR(7),o[1],0,0,0), C1,12); \
    if(GL){ FINIT(P0,P1,(t)+1); } \
    }while(0)
  #define ENDW(tt) do{ if((tt)+3<NT){WAIT_BAR(2);} else if((tt)+2<NT){WAIT_BAR(1);} else {WAIT_BAR(0);} }while(0)
  int t=1;
  for(;t<=3&&t+1<NT;t+=2){
    STEP(pB0,pB1,pA0,pA1,t,(t+3<NT),(t+1<NT),(t+1<NT));       ENDW(t);   RESC(); ROT();
    STEP(pA0,pA1,pB0,pB1,t+1,(t+4<NT),(t+2<NT),(t+2<NT));     ENDW(t+1); RESC(); ROT();
  }
  #undef CMASK
  #define CMASK(P0,P1,t) do{}while(0)
  for(;t+5<NT;t+=2){
    STEP(pB0,pB1,pA0,pA1,t,true,true,true);     WAIT_BAR(2); RESC(); ROT();
    STEP(pA0,pA1,pB0,pB1,t+1,true,true,true);   WAIT_BAR(2); RESC(); ROT();
  }
  for(;t+1<NT;t+=2){
    STEP(pB0,pB1,pA0,pA1,t,(t+3<NT),(t+1<NT),(t+1<NT));       ENDW(t);   RESC(); ROT();
    STEP(pA0,pA1,pB0,pB1,t+1,(t+4<NT),(t+2<NT),(t+2<NT));     ENDW(t+1); RESC(); ROT();
  }
  #undef CMASK
  #define CMASK(P0,P1,t) do{int jb_=3-(t); if(jb_>=0)cmask(P0,P1,jb_,qrel,hi);}while(0)
  STEP(pB0,pB1,pA0,pA1,NT-1,false,false,false); RESC();
  { float sacc=pB0[0]+pB0[1]; _Pragma("unroll") for(int r=2;r<16;++r)sacc+=pB0[r]; _Pragma("unroll") for(int r=0;r<16;++r)sacc+=pB1[r]; l_reg+=sacc;
    pw0=(u32x4){PKW(pB0,0),PKW(pB0,2),PKW(pB0,4),PKW(pB0,6)};pw1=(u32x4){PKW(pB0,8),PKW(pB0,10),PKW(pB0,12),PKW(pB0,14)};pw2=(u32x4){PKW(pB1,0),PKW(pB1,2),PKW(pB1,4),PKW(pB1,6)};pw3=(u32x4){PKW(pB1,8),PKW(pB1,10),PKW(pB1,12),PKW(pB1,14)};
    SBAR(); pv(o,vb0+sl_cur,PAF(0),PAF(1),PAF(2),PAF(3)); }
  #undef PKW
  #undef PAF
  #undef VFR
  #undef PIN
  #undef MX3
  #undef GAPA
  #undef GAPB
  #undef EX
  #undef VRD
  #undef KRD
  #undef STEP
  #undef ENDW
  #undef FINIT
  {auto rr=__builtin_amdgcn_permlane32_swap(__float_as_uint(l_reg),__float_as_uint(l_reg),false,false);l_reg=__uint_as_float(rr[0])+__uint_as_float(rr[1]);}
  if(hi==0)wsf[32+r32]=l_reg;asm volatile("s_waitcnt lgkmcnt(0)":::"memory");
  float rli[16];
  #pragma unroll
  for(int r=0;r<16;++r)rli[r]=__builtin_amdgcn_rcpf(wsf[32+crow(r,hi)]);
  bf16*Ow=O+(rowbase+q0+wid*QBLK)*PO+OCOL+h*D;
  { bf16*stg=(bf16*)(shm+LDS_OST)+wid*2048;
    #pragma unroll
    for(int r=0;r<16;++r){const int orow=crow(r,hi);
      #pragma unroll
      for(int d0=0;d0<2;++d0)stg[orow*64+d0*32+r32]=__float2bfloat16(o[d0][r]*rli[r]);}
    asm volatile("s_waitcnt lgkmcnt(0)":::"memory");
    #pragma unroll
    for(int i=0;i<4;++i){const int row=i*8+(lane>>3),ch=lane&7; const u32x4 v=*(const u32x4*)(stg+row*64+ch*8); ATTN_STORE16(Ow+(long)row*PO+ch*8,v);} }
  asm volatile("s_waitcnt lgkmcnt(0)\n\ts_barrier":::"memory");
  #undef DMA_K
  #undef DMA_V
  #undef CMASK
  #undef START
  #undef RESC
  #undef ROT
}
constexpr int ATTN_LDS_BYTES=LDS_BYTES;
#undef SBAR
#undef WAIT_BAR
}
constexpr int NWAVES = 8;
#ifndef MK_PER_PHASE
#define MK_PER_PHASE 0
#endif
#ifndef MK_USE_CG
#define MK_USE_CG 0
#endif
constexpr int BATCH = 4, SEQ = 8192, D = 1024, FF = 2816, DEPTH = 2, NH = 8;
constexpr int M = BATCH * SEQ;
constexpr int NGU = 2 * FF;
constexpr int NWIN = 2560;
constexpr int IN_COLS = 2312;
constexpr size_t MiB = 1u << 20;
constexpr size_t WS_CTL = 0, CTL_ZERO_BYTES = 64 * 1024;
constexpr size_t WS_SS = 1 * MiB;
constexpr size_t WS_LF = 3 * MiB;
constexpr size_t WS_W = 4 * MiB, W_LAYER = 40 * MiB;
constexpr size_t W_GU1 = 0, W_D1 = 11 * MiB, W_WIN = 16 * MiB + 512 * 1024, W_WOUT = 21 * MiB + 512 * 1024, W_GU2 = 23 * MiB + 512 * 1024, W_D2 = 34 * MiB + 512 * 1024;
constexpr size_t WS_XB = 84 * MiB;
constexpr size_t WS_R = 148 * MiB;
constexpr size_t WS_UP = WS_R, WS_Q = WS_R + 16 * MiB, WS_K = WS_R + 48 * MiB, WS_V = WS_R + 80 * MiB, WS_CU = WS_R + 112 * MiB, WS_Y = WS_R + 128 * MiB;
constexpr size_t WS_END = WS_R + 192 * MiB;
static_assert((size_t)M * FF * 2 <= 192 * MiB && (size_t)NGU * D * 2 == 11 * MiB && (size_t)D * FF * 2 == 5 * MiB + 512 * 1024 && (size_t)NWIN * D * 2 == 5 * MiB, "d_ws map");
constexpr int CW_KMAX = 256;
constexpr int CW_BAR = 1024;
constexpr int RING_OFF = 0, RING_BYTES = 131072;
constexpr int LDSCTL_OFF = RING_BYTES, MISC_OFF = LDSCTL_OFF + 320;
constexpr int LDS_BYTES = 147456;
static_assert(attn_body::ATTN_LDS_BYTES <= RING_BYTES && pg8::STAGE_BYTES <= RING_BYTES, "LDS map");

#define GAS __attribute__((address_space(1)))
#define LAS __attribute__((address_space(3)))
typedef unsigned short bf16;
typedef unsigned v4u __attribute__((ext_vector_type(4)));
typedef unsigned v2u __attribute__((ext_vector_type(2)));
typedef float f32x4 __attribute__((ext_vector_type(4)));
#define RLX_AGENT __ATOMIC_RELAXED, __HIP_MEMORY_SCOPE_AGENT
#define LDS_WAIT() asm volatile("s_waitcnt lgkmcnt(0)" ::: "memory")
__device__ __forceinline__ unsigned f2bf(float f) { unsigned u = __builtin_bit_cast(unsigned, f); return (u + 0x7fffu + ((u >> 16) & 1u)) >> 16; }
__device__ __forceinline__ unsigned pk2(float lo, float hi) { return pg8::cvt_pk_bf16(lo, hi); }
__device__ __forceinline__ float bflo(unsigned w) { return __builtin_bit_cast(float, w << 16); }
__device__ __forceinline__ float bfhi(unsigned w) { return __builtin_bit_cast(float, w & 0xffff0000u); }
template <int CTRL> __device__ __forceinline__ float dpp_mov(float x) { return __builtin_bit_cast(float, __builtin_amdgcn_update_dpp(0, __builtin_bit_cast(int, x), CTRL, 0xf, 0xf, false)); }
__device__ __forceinline__ float wave_sum(float x) {
    x += dpp_mov<0x128>(x); x += dpp_mov<0x124>(x); x += dpp_mov<0x122>(x); x += dpp_mov<0x121>(x);
    const int xi = __builtin_bit_cast(int, x);
    const float r0 = __builtin_bit_cast(float, __builtin_amdgcn_readlane(xi, 0)), r1 = __builtin_bit_cast(float, __builtin_amdgcn_readlane(xi, 16));
    const float r2 = __builtin_bit_cast(float, __builtin_amdgcn_readlane(xi, 32)), r3 = __builtin_bit_cast(float, __builtin_amdgcn_readlane(xi, 48));
    return (r0 + r1) + (r2 + r3);
}
#define XB_TMO      128
#define XB_XCNT(j)  (256  + 64 * (j))
#define XB_XSUB(j)  (1280 + 64 * (j))
#define XB_XGEN(j)  (2304 + 64 * (j))
#define XB_TOP      3328
#define XB_TOPGEN   3392
#define XCD_BAR_WORDS 3456
#define XB_SPIN_CAP (1u << 18)

__device__ __forceinline__ unsigned xb_ld(unsigned* p)              { return __hip_atomic_load(p, __ATOMIC_RELAXED, __HIP_MEMORY_SCOPE_AGENT); }
__device__ __forceinline__ unsigned xb_add(unsigned* p, unsigned v) { return __hip_atomic_fetch_add(p, v, __ATOMIC_RELAXED, __HIP_MEMORY_SCOPE_AGENT); }
__device__ __forceinline__ unsigned xb_xcc_id() { return (unsigned)__builtin_amdgcn_s_getreg((3 << 11) | 20) & 0xFu; }
#define XB_SPIN(cond, bar) do { unsigned _sp = 0; while (cond) { __builtin_amdgcn_s_sleep(1); \
    if ((++_sp & 255u) == 0u) { if (xb_ld(&(bar)[XB_TMO])) break; if (_sp > XB_SPIN_CAP) { atomicAdd(&(bar)[XB_TMO], 1u); break; } } } } while (0)

struct XcdBarrier {
    unsigned* bar; unsigned x;
    volatile LAS unsigned* st;
};

__device__ __forceinline__ XcdBarrier xcd_barrier_post(unsigned* bar, volatile LAS unsigned* st) {
    XcdBarrier b; b.bar = bar; b.x = xb_xcc_id(); b.st = st;
    if (threadIdx.x == 0) (void)xb_add(&bar[XB_XCNT(b.x)], 1u);
    return b;
}
__device__ __forceinline__ void xcd_barrier_complete(unsigned* bar, unsigned x, unsigned& nloc, unsigned& nx) {
    const unsigned G = gridDim.x * gridDim.y * gridDim.z;
    unsigned sum, cnt, mine, sp = 0u;
    for (;;) {
        sum = 0u; cnt = 0u; mine = 0u;
#pragma unroll
        for (unsigned j = 0; j < 16; ++j) { const unsigned c = xb_ld(&bar[XB_XCNT(j)]); sum += c; cnt += (c > 0u) ? 1u : 0u; mine = (j == x) ? c : mine; }
        if (sum == G) break;
        __builtin_amdgcn_s_sleep(1);
        if ((++sp & 255u) == 0u) { if (xb_ld(&bar[XB_TMO])) break; if (sp > XB_SPIN_CAP) { atomicAdd(&bar[XB_TMO], 1u); break; } }
    }
    nloc = mine > 0u ? mine : 1u; nx = cnt > 0u ? cnt : 1u;
}

__device__ __forceinline__ void xcd_barrier(const XcdBarrier& b) {
    asm volatile("s_waitcnt vmcnt(0)" ::: "memory");
    __syncthreads();
    if (threadIdx.x == 0) {
        unsigned* bar = b.bar;
        __builtin_amdgcn_s_waitcnt(0);
        unsigned nloc = b.st[0], nx = b.st[1];
        if (nloc == 0u) { xcd_barrier_complete(bar, b.x, nloc, nx); b.st[0] = nloc; b.st[1] = nx; }
        const unsigned old = xb_add(&bar[XB_XSUB(b.x)], 1u);
        const unsigned gen = old / nloc;
        if (old + 1u == (gen + 1u) * nloc) {
            __builtin_amdgcn_fence(__ATOMIC_RELEASE, "agent");
            asm volatile("s_waitcnt vmcnt(0)" ::: "memory");
            const unsigned og = xb_add(&bar[XB_TOP], 1u);
            const unsigned tg = og / nx;
            if (og + 1u == (tg + 1u) * nx) xb_add(&bar[XB_TOPGEN], 1u);
            else XB_SPIN(xb_ld(&bar[XB_TOPGEN]) == tg, bar);
            __builtin_amdgcn_fence(__ATOMIC_ACQUIRE, "agent");
            xb_add(&bar[XB_XGEN(b.x)], 1u);
            asm volatile("s_waitcnt vmcnt(0)" ::: "memory");
        } else {
            XB_SPIN(xb_ld(&bar[XB_XGEN(b.x)]) == gen, bar);
            __builtin_amdgcn_fence(__ATOMIC_ACQUIRE, "agent");
            asm volatile("s_waitcnt vmcnt(0)" ::: "memory");
        }
    }
    __syncthreads();
}
__device__ __forceinline__ void tr_item(const float* W, int N, int col0, int ncols, int k0, const float* gain, bf16* WT, int K, int drow0, LAS float* scr, int lane) {
    const int c = lane & 31; float tv[32];
    const float* wp = W + (size_t)(k0 + (lane >> 5)) * N + col0 + (c < ncols ? c : 0); const float gsel = (c < ncols) ? 1.f : 0.f;
#pragma unroll
    for (int i = 0; i < 32; ++i) tv[i] = wp[(size_t)(2 * i) * N];
    if (gain) {
#pragma unroll
        for (int i = 0; i < 32; ++i) tv[i] *= gain[k0 + 2 * i + (lane >> 5)]; }
#pragma unroll
    for (int i = 0; i < 32; ++i) scr[(2 * i + (lane >> 5)) * 33 + c] = tv[i] * gsel;
    LDS_WAIT(); asm volatile("" ::: "memory");
    const int c8 = lane & 7;
#pragma unroll
    for (int j = 0; j < 4; ++j) { const int n = (lane >> 3) + 8 * j; const LAS float* s = scr + (8 * c8) * 33 + n;
        v4u o; o.x = pk2(s[0 * 33], s[1 * 33]); o.y = pk2(s[2 * 33], s[3 * 33]); o.z = pk2(s[4 * 33], s[5 * 33]); o.w = pk2(s[6 * 33], s[7 * 33]);
        *(GAS v4u*)(WT + (size_t)(drow0 + n) * K + k0 + 8 * c8) = o; }
    LDS_WAIT(); asm volatile("" ::: "memory");
}
struct Args { const float* in[20]; float* out; unsigned char* ws; int ph_lo, ph_hi; };
#define PIn Args
__device__ __forceinline__ void p0_prologue(const PIn& P, unsigned char* ws, LAS unsigned char* lds, int vcu, int G, int wave, int lane) {
    { int t_ = threadIdx.x; asm volatile("" : "+v"(t_)); lane = t_ & 63; wave = __builtin_amdgcn_readfirstlane(t_ >> 6); }
    LAS float* scr = (LAS float*)(lds + RING_OFF + wave * 16384);
    const int gw = vcu * NWAVES + wave, NGW = G * NWAVES;
    constexpr int I_G = (D / 64) * (FF / 32), I_DN = (FF / 64) * (D / 32), I_IN = (D / 64) * 73, I_OUT = 12 * (D / 32);
    constexpr int PER_LAYER = 6 * I_G + I_IN + I_OUT;
    static_assert(I_G == I_DN, "item counts");
    for (int it = gw; it < DEPTH * PER_LAYER; it += NGW) {
        const int l = it / PER_LAYER; int r = it - l * PER_LAYER;
        unsigned char* wl = ws + WS_W + (size_t)l * W_LAYER;
        if (r < 3 * I_G || r >= 3 * I_G + I_IN + I_OUT) {
            const bool second = r >= 3 * I_G; if (second) r -= 3 * I_G + I_IN + I_OUT;
            const int which = r / I_G; r -= which * I_G;
            const float* nrm = (second ? P.in[15] : P.in[1]) + (size_t)l * D;
            if (which < 2) { const float* W = (second ? (which ? P.in[17] : P.in[16]) : (which ? P.in[3] : P.in[2])) + (size_t)l * D * FF; const int kb = r / (FF / 32), nb = r % (FF / 32), n0 = 32 * nb;
                tr_item(W, FF, n0, 32, 64 * kb, nrm, (bf16*)(wl + (second ? W_GU2 : W_GU1)), D, 256 * (n0 >> 7) + (n0 & 127) + 128 * which, scr, lane); }
            else { const float* W = (second ? P.in[18] : P.in[4]) + (size_t)l * FF * D; const int kb = r / (D / 32), nb = r % (D / 32);
                tr_item(W, D, 32 * nb, 32, 64 * kb, nullptr, (bf16*)(wl + (second ? W_D2 : W_D1)), FF, 32 * nb, scr, lane); }
            continue;
        }
        r -= 3 * I_G;
        if (r < I_IN) {
            const float* W = P.in[6] + (size_t)l * D * IN_COLS; const float* nrm = P.in[5] + (size_t)l * D; const int kb = r / 73, nb = r % 73;
            int col0, ncols = 32, drow0;
            if (nb < 56) { col0 = 32 * nb; drow0 = 32 * nb; }
            else if (nb < 64) { const int j = 32 * (nb - 56); col0 = 1800 + j; drow0 = 1792 + 256 * (j >> 7) + (j & 127); }
            else if (nb < 72) { const int j = 32 * (nb - 64); col0 = 2056 + j; drow0 = 1792 + 256 * (j >> 7) + 128 + (j & 127); }
            else { col0 = 1792; ncols = 8; drow0 = 2304; }
            tr_item(W, IN_COLS, col0, ncols, 64 * kb, nrm, (bf16*)(wl + W_WIN), D, drow0, scr, lane);
            continue;
        }
        r -= I_IN;
        { const float* W = P.in[14] + (size_t)l * D * D; const int kb = r / (D / 32), nb = r % (D / 32);
          tr_item(W, D, 32 * nb, 32, 256 + 64 * kb, nullptr, (bf16*)(wl + W_WOUT), D, 32 * nb, scr, lane); }
    }
    { const int gt = gw * 64 + lane, NT_ = NGW * 64;
      for (int e = gt; e < DEPTH * D * 256; e += NT_) { const int l = e / (D * 256), r = e - l * (D * 256), n = r >> 8, k = r & 255, g = k >> 6, c = k & 63;
          const float* pw = P.in[7] + ((size_t)((l * 4 + g) * 64 + c)) * 64; const float* ps = P.in[8] + (size_t)l * 256 + 64 * g; const float* wo = P.in[14] + (size_t)l * D * D + (size_t)(64 * g) * D + n;
          float s = 0.f;
#pragma unroll 8
          for (int d = 0; d < 64; ++d) s += pw[d] * ps[d] * wo[(size_t)d * D];
          ((bf16*)(ws + WS_W + (size_t)l * W_LAYER + W_WOUT))[(size_t)n * D + k] = (bf16)f2bf(s); } }
    { const float* x = P.in[0]; bf16* XB = (bf16*)(ws + WS_XB); float* SS = (float*)(ws + WS_SS);
      for (int m0 = gw * 4; m0 < M; m0 += NGW * 4) { f32x4 v[4][4];
#pragma unroll
          for (int q = 0; q < 4; ++q) { const GAS f32x4* xr = (const GAS f32x4*)(x + (size_t)(m0 + q) * D) + lane;
#pragma unroll
              for (int j = 0; j < 4; ++j) v[q][j] = xr[64 * j]; }
#pragma unroll
          for (int q = 0; q < 4; ++q) { const int m = m0 + q; float s = 0.f;
#pragma unroll
              for (int j = 0; j < 4; ++j) s += (v[q][j].x * v[q][j].x + v[q][j].y * v[q][j].y) + (v[q][j].z * v[q][j].z + v[q][j].w * v[q][j].w);
              s = wave_sum(s);
              GAS unsigned long long* o8 = (GAS unsigned long long*)(XB + (size_t)m * D) + lane;
#pragma unroll
              for (int j = 0; j < 4; ++j) o8[64 * j] = (unsigned long long)pk2(v[q][j].x, v[q][j].y) | ((unsigned long long)pk2(v[q][j].z, v[q][j].w) << 32);
              if (lane < 16) SS[(size_t)m * 16 + lane] = lane == 0 ? s : 0.f; } } }
}
__device__ __forceinline__ f32x4 unpk4(v2u v) { return (f32x4){bflo(v.x), bfhi(v.x), bflo(v.y), bfhi(v.y)}; }
__device__ __forceinline__ void mix_local(LAS unsigned char* lds, int vcu, int G, const bf16* UP, const bf16* CU, bf16* Y, const float* cw, const float* cb, const float* lg, const float* lb) {
    int t_ = threadIdx.x; asm volatile("" : "+v"(t_)); const int lane = t_ & 63, wave = __builtin_amdgcn_readfirstlane(t_ >> 6);
    LAS float* wl = (LAS float*)(lds + RING_OFF);
    { f32x4 tv[4];
#pragma unroll
      for (int q = 0; q < 4; ++q) { const int i = wave * 64 + lane + q * NWAVES * 64; tv[q] = *((const f32x4*)cw + (i < 1984 ? i : 0)); }
#pragma unroll
      for (int q = 0; q < 4; ++q) { const int i = wave * 64 + lane + q * NWAVES * 64; if (i < 1984) *((LAS f32x4*)wl + i) = tv[q]; } }
    __syncthreads();
    const int grp = lane >> 4, wwin = 2 << grp; const unsigned lane8 = 8u * (unsigned)lane;
#pragma unroll 1
    for (int un = vcu * NWAVES + wave; un < M / 16; un += G * NWAVES) {
        const int row0 = un * 16, t0 = row0 & (SEQ - 1);
        v2u pr[31], cr[46];
#pragma unroll
        for (int k = 0; k < 31; ++k) { const bool in = t0 - 15 + k >= 0; const unsigned msk = in ? 0xffffffffu : 0u; const bf16* rp = UP + (size_t)(in ? row0 - 15 + k : row0) * 256; pr[k] = *(const GAS v2u*)((const GAS char*)rp + lane8); pr[k].x &= msk; pr[k].y &= msk; }
#pragma unroll
        for (int k = 0; k < 46; ++k) { const bool in = t0 - 30 + k >= 0; const unsigned msk = in ? 0xffffffffu : 0u; const bf16* rp = CU + (size_t)(in ? row0 - 30 + k : row0) * 256; cr[k] = *(const GAS v2u*)((const GAS char*)rp + lane8); cr[k].x &= msk; cr[k].y &= msk; }
        __builtin_amdgcn_sched_barrier(0);
        {
            f32x4 S = {0.f, 0.f, 0.f, 0.f};
#pragma unroll
            for (int k = 0; k < 16; ++k) { const f32x4 f = unpk4(pr[15 - k]); if (k < wwin) S += f; }
#pragma unroll
            for (int i = 0; i < 16; ++i) {
                const f32x4 cur = unpk4(pr[15 + i]);
                if (i > 0) { const v2u o = (grp == 0) ? pr[15 + i - 2] : (grp == 1) ? pr[15 + i - 4] : (grp == 2) ? pr[15 + i - 8] : pr[15 + i - 16]; S += cur - unpk4(o); }
                const int t = t0 + i, cnt = (t + 1 < wwin) ? t + 1 : wwin;
                const f32x4 p = S * __builtin_amdgcn_rcpf((float)cnt) - cur;
                v2u o2; o2.x = pg8::cvt_pk_bf16(p[0], p[1]); o2.y = pg8::cvt_pk_bf16(p[2], p[3]); *(GAS v2u*)(Y + (size_t)(row0 + i) * D + 4 * lane) = o2;
            }
        }
        __builtin_amdgcn_sched_barrier(0);
        const f32x4 cb4 = *(const f32x4*)(cb + 4 * lane), g4 = *(const f32x4*)(lg + 4 * lane), b4 = *(const f32x4*)(lb + 4 * lane);
#pragma unroll 1
        for (int gi = 0; gi < 2; ++gi) {
            f32x4 acc[8];
#pragma unroll
            for (int i = 0; i < 8; ++i) acc[i] = cb4;
#pragma unroll
            for (int hf = 0; hf < 2; ++hf) {
                constexpr int JN[2] = {16, 15}; const int jlo = 16 * hf;
                f32x4 wv[16];
#pragma unroll
                for (int j = 0; j < 16; ++j) if (j < JN[hf]) wv[j] = *(const LAS f32x4*)(wl + (jlo + j) * 256 + 4 * lane);
#pragma unroll
                for (int rr = 0; rr < 23; ++rr) if (rr < JN[hf] + 7) {
                    const f32x4 f = unpk4(cr[jlo + rr]);
#pragma unroll
                    for (int i = 0; i < 8; ++i) { const int j = rr - i; if (j >= 0 && j < JN[hf]) acc[i] += wv[j] * f; } }
                __builtin_amdgcn_sched_barrier(0);
            }
#pragma unroll
            for (int i = 0; i < 8; ++i) { const f32x4 a = acc[i];
                const float mean = wave_sum((a[0] + a[1]) + (a[2] + a[3])) * (1.0f / 256.0f); const f32x4 d = a - mean;
                const float var = wave_sum((d[0] * d[0] + d[1] * d[1]) + (d[2] * d[2] + d[3] * d[3])) * (1.0f / 256.0f); const float rs = __builtin_amdgcn_rsqf(var + 1e-6f);
                const f32x4 yn = d * rs * g4 + b4; f32x4 o4;
#pragma unroll
                for (int q = 0; q < 4; ++q) o4[q] = yn[q] * pg8::sigm(yn[q]);
                v2u o; o.x = pg8::cvt_pk_bf16(o4[0], o4[1]); o.y = pg8::cvt_pk_bf16(o4[2], o4[3]); *(GAS v2u*)(Y + (size_t)(row0 + 8 * gi + i) * D + 768 + 4 * lane) = o; }
#pragma unroll
            for (int k = 0; k < 38; ++k) cr[k] = cr[k + 8];
            __builtin_amdgcn_sched_barrier(0);
        }
    }
    __syncthreads();
}
__device__ __forceinline__ void final_norm(float* X, const bf16* XB, const float* SS, const float* g, int vcu, int G, int wave, int lane) {
    { int t_ = threadIdx.x; asm volatile("" : "+v"(t_)); lane = t_ & 63; wave = __builtin_amdgcn_readfirstlane(t_ >> 6); }
    const int gw = vcu * NWAVES + wave, NGW = G * NWAVES;
    f32x4 gv[4];
#pragma unroll
    for (int j = 0; j < 4; ++j) gv[j] = *((const f32x4*)g + lane + 64 * j);
    for (int m0 = gw * 2; m0 < M; m0 += NGW * 2) {
        v2u v[2][4]; float ri[2];
#pragma unroll
        for (int q = 0; q < 2; ++q) { const GAS v2u* xr = (const GAS v2u*)(XB + (size_t)(m0 + q) * D) + lane;
#pragma unroll
            for (int j = 0; j < 4; ++j) v[q][j] = xr[64 * j]; ri[q] = pg8::row_rinv(SS, m0 + q); }
#pragma unroll
        for (int q = 0; q < 2; ++q) { GAS f32x4* orow = (GAS f32x4*)(X + (size_t)(m0 + q) * D) + lane;
#pragma unroll
            for (int j = 0; j < 4; ++j) orow[64 * j] = unpk4(v[q][j]) * ri[q] * gv[j]; } }
}

constexpr int RT_OFF = LDSCTL_OFF + 1024;
static_assert(RT_OFF + 4096 <= LDS_BYTES, "LDS map");
__device__ __forceinline__ const LAS float* fill_rinv(LAS unsigned char* lds, const pg8::StaticOrder& S, const float* SS) {
    int tid_ = threadIdx.x; asm volatile("" : "+v"(tid_));
    LAS float* rt = (LAS float*)(lds + RT_OFF);
    pg8::Unit u; int sp0 = -1, sp1 = -1, sp2 = -1, sp3 = -1; bool ok = true;
    for (int i = 0; S.next(i, u); ++i) { const int sl = (u.pm >> 3) & 3; const int cur = sl == 0 ? sp0 : sl == 1 ? sp1 : sl == 2 ? sp2 : sp3;
        if (cur != u.pm) { if (cur != -1) ok = false;
            if (sl == 0) sp0 = u.pm; else if (sl == 1) sp1 = u.pm; else if (sl == 2) sp2 = u.pm; else sp3 = u.pm;
            if (tid_ < 256) rt[sl * 256 + tid_] = pg8::row_rinv(SS, u.pm * 256 + tid_); } }
    __syncthreads();
    return ok ? (const LAS float*)rt : (const LAS float*)nullptr;
}
constexpr int N_PHASES = 2 + 7 * DEPTH;

__global__ void __launch_bounds__(NWAVES * 64, 2) mk_fwd(Args args) {
#ifndef LAYOUT_PAD
#define LAYOUT_PAD 24
#endif
    if (LAYOUT_PAD) asm volatile(".fill %0, 4, 0xBF800000" :: "n"(LAYOUT_PAD));
    extern __shared__ __attribute__((aligned(16))) unsigned char lds_raw[];
    LAS unsigned char* lds = (LAS unsigned char*)lds_raw;
    volatile LAS unsigned* MISC = (volatile LAS unsigned*)(lds + MISC_OFF);
    const int tid = threadIdx.x, lane = tid & 63, wave = __builtin_amdgcn_readfirstlane(tid >> 6);
    const int G = gridDim.x; const int bx = blockIdx.x; const int vcu = (G % 8 == 0) ? (bx % 8) * (G / 8) + bx / 8 : bx;
    unsigned char* ws = args.ws;
    cg::grid_group grid = cg::this_grid();
    for (int u = tid; u < (LDS_BYTES - LDSCTL_OFF) / 4; u += NWAVES * 64) ((LAS unsigned*)(lds + LDSCTL_OFF))[u] = 0u;
    __syncthreads();
#if !MK_USE_CG
    XcdBarrier bar = xcd_barrier_post((unsigned*)(ws + WS_CTL) + CW_BAR, MISC + 8);
#define GRID_BAR() xcd_barrier(bar)
#else
#define GRID_BAR() grid.sync()
#endif
    const int lo = args.ph_lo, hi = args.ph_hi;
#define IN(k) (lo <= (k) && (k) < hi)
#define SEAM(k) do { if (IN(k) && IN((k) + 1)) GRID_BAR(); } while (0)
    float* X = args.out;
    bf16* XB = (bf16*)(ws + WS_XB); float* SS = (float*)(ws + WS_SS); float* LF2 = (float*)(ws + WS_LF);
    bf16* HB = (bf16*)(ws + WS_R); bf16* UP = (bf16*)(ws + WS_UP); bf16* QB_ = (bf16*)(ws + WS_Q); bf16* KB = (bf16*)(ws + WS_K); bf16* VB = (bf16*)(ws + WS_V);
    bf16* CUB = (bf16*)(ws + WS_CU); bf16* YB = (bf16*)(ws + WS_Y);

    if (IN(0)) {
#ifndef REP_P0
#define REP_P0 1
#endif
        for (int rep_ = 0; rep_ < REP_P0; ++rep_) { p0_prologue(args, ws, lds, vcu, G, wave, lane); __syncthreads(); }
        __syncthreads();
        if (IN(1)) GRID_BAR();
        if (hi < 0) grid.sync();
    }
#pragma unroll 1
    for (int l = 0; l < DEPTH; ++l) {
        const int p0 = 1 + 7 * l;
        unsigned char* wl = ws + WS_W + (size_t)l * W_LAYER;
#pragma unroll 1
        for (int f = 0; f < 2; ++f) {
            const int pa = p0 + 5 * f;
            if (IN(pa)) {
                pg8::Gemm g{XB, (const bf16*)(wl + (f ? W_GU2 : W_GU1)), M, NGU, D}; pg8::StaticOrder S; S.init(M, NGU, G, bx);
                pg8::EpiGLU E{HB, FF, SS, fill_rinv(lds, S, SS)};
#ifndef REP_GLU
#define REP_GLU 1
#endif
                for (int rep_ = 0; rep_ < REP_GLU; ++rep_) pg8::gemm_phase<pg8::EpiGLU, pg8::StaticOrder, true, true>(lds + RING_OFF, g, S, E);
            }
            SEAM(pa);
            if (IN(pa + 1)) {
                pg8::Gemm g{HB, (const bf16*)(wl + (f ? W_D2 : W_D1)), M, D, FF}; pg8::StaticOrder S; S.init(M, D, G, bx);
                { pg8::EpiRes<false, false> E{nullptr, nullptr, XB, SS, 0.5f}; pg8::gemm_phase<pg8::EpiRes<false, false>, pg8::StaticOrder, true, true>(lds + RING_OFF, g, S, E); }
            }
            SEAM(pa + 1);
            if (f == 0) {
                if (IN(p0 + 2)) {
                    pg8::Gemm g{XB, (const bf16*)(wl + W_WIN), M, NWIN, D}; pg8::StaticOrder S; S.init(M, NWIN, G, bx);
                    pg8::EpiWin E{UP, QB_, KB, VB, CUB, LF2, SS, args.in[9] + (size_t)l * NH, attn_body::C2, SEQ, (unsigned*)(ws + WS_CTL) + CW_KMAX + 32 * l, fill_rinv(lds, S, SS)};
#ifndef REP_WIN
#define REP_WIN 1
#endif
                    for (int rep_ = 0; rep_ < REP_WIN; ++rep_) pg8::gemm_phase<pg8::EpiWin, pg8::StaticOrder, true, true>(lds + RING_OFF, g, S, E);
                }
                SEAM(p0 + 2);
                if (IN(p0 + 3)) {
#ifndef REP_MIX
#define REP_MIX 1
#endif
                  for (int rep_ = 0; rep_ < REP_MIX; ++rep_) {
#ifndef DIS_MIX
                    mix_local(lds, vcu, G, UP, CUB, YB, args.in[10] + (size_t)l * 31 * 256, args.in[11] + (size_t)l * 256, args.in[12] + (size_t)l * 256, args.in[13] + (size_t)l * 256);
#endif
#ifndef DIS_ATTN
                    for (int v = vcu; v < 256; v += G) { const int bh = v >> 3, s = v & 7;
                        attn_body::attn_scan(bh / NH, bh % NH, LF2, (char*)lds_raw + RING_OFF);
                        const float km = 2.04f * __uint_as_float(__hip_atomic_load((const unsigned*)(ws + WS_CTL) + CW_KMAX + 32 * l + bh, __ATOMIC_RELAXED, __HIP_MEMORY_SCOPE_AGENT));
#pragma unroll 1
                        for (int i = 0; i < 4; ++i) { const int qb = (i == 0) ? s : (i == 1) ? 15 - s : (i == 2) ? 16 + s : 31 - s;
                            attn_body::attn_unit<8>(bh / NH, bh % NH, qb, (const attn_body::bf16*)QB_, (const attn_body::bf16*)KB, (const attn_body::bf16*)VB, (attn_body::bf16*)YB, LF2, km, (char*)lds_raw + RING_OFF); } }
#endif
                  }
                }
                SEAM(p0 + 3);
                if (IN(p0 + 4)) {
                    pg8::Gemm g{YB, (const bf16*)(wl + W_WOUT), M, D, D}; pg8::StaticOrder S; S.init(M, D, G, bx);
                    pg8::EpiRes<false, false> E{nullptr, nullptr, XB, SS, 1.0f};
                    pg8::gemm_phase<pg8::EpiRes<false, false>, pg8::StaticOrder, true, true>(lds + RING_OFF, g, S, E);
                }
                SEAM(p0 + 4);
            }
        }
    }
    if (IN(N_PHASES - 1)) final_norm(X, XB, SS, args.in[19], vcu, G, wave, lane);
#undef IN
#undef SEAM
}

extern "C" void kernel_launch(void* const* d_in, const int* in_sizes, int n_in, void* d_out, int out_size, void* d_ws, size_t ws_size, hipStream_t stream) {
    static int grid = 0;
    if (grid == 0) {
        if (n_in != 20 || in_sizes[0] != M * D || out_size != M * D || ws_size < WS_END) { fprintf(stderr, "kernel_launch: unexpected shapes (n_in %d, in0 %d, out %d, ws %zu); nothing launched\n", n_in, n_in > 0 ? in_sizes[0] : -1, out_size, ws_size); grid = -1; return; }
        int dev = 0, cus = 0, per_cu = 0;
        if (hipGetDevice(&dev) != hipSuccess || hipDeviceGetAttribute(&cus, hipDeviceAttributeMultiprocessorCount, dev) != hipSuccess) { grid = -1; return; }
        if (hipFuncSetAttribute((const void*)mk_fwd, hipFuncAttributeMaxDynamicSharedMemorySize, LDS_BYTES) != hipSuccess) { fprintf(stderr, "kernel_launch: hipFuncSetAttribute failed\n"); grid = -1; return; }
        if (hipOccupancyMaxActiveBlocksPerMultiprocessor(&per_cu, (const void*)mk_fwd, NWAVES * 64, LDS_BYTES) != hipSuccess || per_cu < 1) per_cu = 1;
        (void)hipGetLastError();
        grid = cus;
    }
    if (grid < 0) return;
    (void)hipMemsetAsync((char*)d_ws + WS_CTL, 0, CTL_ZERO_BYTES, stream);
    Args a{};
    for (int i = 0; i < 20; ++i) a.in[i] = (const float*)d_in[i];
    a.out = (float*)d_out; a.ws = (unsigned char*)d_ws;
#if MK_PER_PHASE
    for (int p = 0; p < N_PHASES; ++p) { a.ph_lo = p; a.ph_hi = p + 1; void* kargs[] = {&a};
        hipError_t e = hipLaunchCooperativeKernel((const void*)mk_fwd, dim3(grid), dim3(NWAVES * 64), kargs, LDS_BYTES, stream);
        if (e != hipSuccess) { fprintf(stderr, "kernel_launch: cooperative launch %d failed: %s\n", p, hipGetErrorString(e)); break; } }
#else
    a.ph_lo = 0; a.ph_hi = N_PHASES; void* kargs[] = {&a};
    hipError_t e = hipLaunchCooperativeKernel((const void*)mk_fwd, dim3(grid), dim3(NWAVES * 64), kargs, LDS_BYTES, stream);
    if (e != hipSuccess) fprintf(stderr, "kernel_launch: cooperative launch failed: %s (grid %d)\n", hipGetErrorString(e), grid);
#endif
}
```
